# Optimizing an MI355X kernel written in HIP

```python
import math
import jax, jax.numpy as jnp
from jax import lax
import numpy as np

D_MODEL = 2048
BATCH = 4
SEQ = 2048
DEPTH = 4

GRID_W = 64
CTX_LEN = 256
MIX_W = 1024
N_BRANCH = 3
ML_HEADS = 4
ML_DH = MIX_W // ML_HEADS
ML_CHUNK = 64
ML_CONV = 3
S5_GROUP = 16
S5_GROUPS = MIX_W // S5_GROUP
S5_STATE = 64
DA_HEADS = 8
DA_DQK = 64
DA_DV = 2 * DA_DQK
DA_QBLOCK = 128
ROPE_BASE = 10000.0
N_EXPERTS = 16
N_EXPERT_GROUPS = 4
EXPERTS_PER_GROUP = N_EXPERTS // N_EXPERT_GROUPS
TOP_K = 2
D_FF_EXPERT = 512
EPS = 1e-6

IN_SPLIT_SIZES = (MIX_W, MIX_W, MIX_W, MIX_W, 4 * ML_HEADS,
                  MIX_W,
                  DA_HEADS * 2 * DA_DQK, DA_HEADS * 2 * DA_DQK, DA_HEADS * DA_DV,
                  N_BRANCH * D_MODEL)
IN_COLS = sum(IN_SPLIT_SIZES)
IN_SPLIT_POINTS = tuple(sum(IN_SPLIT_SIZES[:j + 1]) for j in range(len(IN_SPLIT_SIZES) - 1))

kernel_name = "hybrid_mlstm_s5_diffattn_moe_dit"

F32 = jnp.float32


def rmsnorm(x, g):
    x32 = x.astype(F32)
    y = x32 * lax.rsqrt(jnp.mean(x32 * x32, -1, keepdims=True) + EPS)
    return (y * g.astype(F32)).astype(x.dtype)


def conv_centred(x, w, b):
    K = w.shape[0]
    L = x.shape[1]
    pad = K // 2
    xp = jnp.pad(x, ((0, 0), (pad, pad), (0, 0)))
    y = b
    for j in range(K):
        y = y + xp[:, j:j + L] * w[j]
    return y


def mlstm_chunks(q, k, v, ig, lf, state):
    Bsz, H, L, dh = q.shape
    nc = L // ML_CHUNK

    def to_chunks(a):
        a = a.reshape(a.shape[:2] + (nc, ML_CHUNK) + a.shape[3:])
        return jnp.moveaxis(a, 2, 0)

    tril = jnp.tril(jnp.ones((ML_CHUNK, ML_CHUNK), bool))

    def step(carry, inp):
        C, n, m = carry
        qc, kc, vc, ic, fc = inp
        b = jnp.cumsum(fc, -1)
        log_inter = b + m[..., None]
        log_intra = jnp.where(tril, b[..., :, None] - b[..., None, :] + ic[..., None, :], -jnp.inf)
        m_t = jnp.maximum(log_inter, log_intra.max(-1))
        w_inter = jnp.exp(log_inter - m_t)
        s = jnp.einsum('bhtd,bhsd->bhts', qc, kc) * jnp.exp(log_intra - m_t[..., None])
        num = w_inter[..., None] * jnp.einsum('bhed,bhtd->bhte', C, qc) + jnp.einsum('bhts,bhse->bhte', s, vc)
        den = w_inter * jnp.einsum('bhd,bhtd->bht', n, qc) + s.sum(-1)
        h = num / jnp.maximum(jnp.abs(den), jnp.exp(-m_t))[..., None]
        b_last = b[..., -1]
        log_w = b_last[..., None] - b + ic
        m_new = jnp.maximum(b_last + m, log_w.max(-1))
        decay = jnp.exp(b_last + m - m_new)
        w_s = jnp.exp(log_w - m_new[..., None])
        C_new = decay[..., None, None] * C + jnp.einsum('bhse,bhsd->bhed', vc * w_s[..., None], kc)
        n_new = decay[..., None] * n + jnp.einsum('bhs,bhsd->bhd', w_s, kc)
        return (C_new, n_new, m_new), h

    state, h = lax.scan(step, state, tuple(to_chunks(a) for a in (q, k, v, ig, lf)))
    h = jnp.moveaxis(h, 0, 2).reshape(Bsz, H, L, dh)
    return h, state


def mlstm_branch(qa, ka, va, oa, gates, conv_w, conv_b, norm_g, n_ctx):
    Bsz, N, _ = qa.shape
    qk = jnp.concatenate([qa, ka], -1)
    qk = jax.nn.silu(jnp.concatenate([conv_centred(qk[:, :n_ctx], conv_w, conv_b),
                                      conv_centred(qk[:, n_ctx:], conv_w, conv_b)], 1))

    def heads(a):
        return a.reshape(Bsz, N, ML_HEADS, ML_DH).transpose(0, 2, 1, 3).astype(F32)

    q = heads(qk[..., :MIX_W])
    k = heads(qk[..., MIX_W:]) * (ML_DH ** -0.5)
    v = heads(va)
    g = gates.astype(F32).reshape(Bsz, N, 4, ML_HEADS).transpose(2, 0, 3, 1)
    zero = (jnp.zeros((Bsz, ML_HEADS, ML_DH, ML_DH), F32),
            jnp.zeros((Bsz, ML_HEADS, ML_DH), F32),
            jnp.zeros((Bsz, ML_HEADS), F32))
    outs = []
    for d in range(2):
        ig, lf = g[2 * d], jax.nn.log_sigmoid(g[2 * d + 1])
        rev = (lambda a: jnp.flip(a, 2)) if d == 1 else (lambda a: a)
        seqs = (q, k, v, ig, lf)
        h_ctx, st = mlstm_chunks(*[rev(a[:, :, :n_ctx]) for a in seqs], zero)
        h_lat, _ = mlstm_chunks(*[rev(a[:, :, n_ctx:]) for a in seqs], st)
        outs.append(jnp.concatenate([rev(h_ctx), rev(h_lat)], 2))
    h = (outs[0] + outs[1]).transpose(0, 2, 1, 3)
    h = rmsnorm(h, norm_g.reshape(ML_HEADS, ML_DH)).reshape(Bsz, N, MIX_W)
    return (jax.nn.sigmoid(oa.astype(F32)) * h).astype(qa.dtype)


def s5_discretize(lam_re, lam_im, log_dt, b_re, b_im):
    lam_re, lam_im = lam_re.astype(F32), lam_im.astype(F32)
    b_re, b_im = b_re.astype(F32), b_im.astype(F32)
    dt = jnp.exp(log_dt.astype(F32))[:, None]
    mag = jnp.exp(lam_re * dt)
    a_re, a_im = mag * jnp.cos(lam_im * dt), mag * jnp.sin(lam_im * dt)
    nr, ni = a_re - 1.0, a_im
    den = lam_re * lam_re + lam_im * lam_im
    fr = (nr * lam_re + ni * lam_im) / den
    fi = (ni * lam_re - nr * lam_im) / den
    bb_re = fr[..., None] * b_re - fi[..., None] * b_im
    bb_im = fr[..., None] * b_im + fi[..., None] * b_re
    return (a_re, a_im), (bb_re, bb_im)


def s5_scan_out(u, a, bb, c_re, c_im, s0):
    a_re, a_im = a
    bu_re = jnp.einsum('blgi,gpi->blgp', u, bb[0])
    bu_im = jnp.einsum('blgi,gpi->blgp', u, bb[1])
    bu_re = bu_re.at[:, 0].add(a_re * s0[0] - a_im * s0[1])
    bu_im = bu_im.at[:, 0].add(a_re * s0[1] + a_im * s0[0])

    def combine(e1, e2):
        ar1, ai1, br1, bi1 = e1
        ar2, ai2, br2, bi2 = e2
        return (ar2 * ar1 - ai2 * ai1, ar2 * ai1 + ai2 * ar1,
                ar2 * br1 - ai2 * bi1 + br2, ar2 * bi1 + ai2 * br1 + bi2)

    elems = (jnp.broadcast_to(a_re, bu_re.shape), jnp.broadcast_to(a_im, bu_im.shape), bu_re, bu_im)
    _, _, s_re, s_im = lax.associative_scan(combine, elems, axis=1)
    y = (jnp.einsum('gip,blgp->blgi', c_re.astype(F32), s_re)
         - jnp.einsum('gip,blgp->blgi', c_im.astype(F32), s_im))
    return y, (s_re[:, -1], s_im[:, -1])


def s5_branch(u, lam_re, lam_im, log_dt, b_re, b_im, c_re, c_im, d_skip, glu_w, glu_b, n_ctx):
    Bsz, N, W = u.shape
    u32 = u.astype(F32)
    ug = u32.reshape(Bsz, N, S5_GROUPS, S5_GROUP)
    zero = (jnp.zeros((Bsz, S5_GROUPS, S5_STATE), F32), jnp.zeros((Bsz, S5_GROUPS, S5_STATE), F32))
    y = d_skip.astype(F32) * u32
    for d in range(2):
        a, bb = s5_discretize(lam_re[d], lam_im[d], log_dt[d], b_re[d], b_im[d])
        rev = (lambda t: jnp.flip(t, 1)) if d == 1 else (lambda t: t)
        y_ctx, st = s5_scan_out(rev(ug[:, :n_ctx]), a, bb, c_re, c_im, zero)
        y_lat, _ = s5_scan_out(rev(ug[:, n_ctx:]), a, bb, c_re, c_im, st)
        y = y + jnp.concatenate([rev(y_ctx), rev(y_lat)], 1).reshape(Bsz, N, W)
    z = jax.nn.gelu(y)
    return (z * jax.nn.sigmoid(z @ glu_w.astype(F32) + glu_b.astype(F32))).astype(u.dtype)


def rope_1d(x, pos):
    half = x.shape[-1] // 2
    freqs = ROPE_BASE ** (-jnp.arange(half, dtype=F32) / half)
    ang = pos.astype(F32)[:, None] * freqs
    cos = jnp.cos(ang)[:, None, None, :]
    sin = jnp.sin(ang)[:, None, None, :]
    x32 = x.astype(F32)
    x1, x2 = x32[..., :half], x32[..., half:]
    return jnp.concatenate([x1 * cos - x2 * sin, x1 * sin + x2 * cos], -1).astype(x.dtype)


def rope_2d(x, rows, cols):
    half = x.shape[-1] // 2
    return jnp.concatenate([rope_1d(x[..., :half], rows), rope_1d(x[..., half:], cols)], -1)


def diff_attn(q, k, v, lam):
    s = jnp.einsum('bhqcd,bhkcd->cbhqk', q, k).astype(F32) * (DA_DQK ** -0.5)
    p = jax.nn.softmax(s, -1)
    a = (p[0] - lam * p[1]).astype(v.dtype)
    return jnp.einsum('bhqk,bhkd->bhqd', a, v)


def diff_branch(qd, kd, vd, qn_g, kn_g, lq1, lk1, lq2, lk2, sub_g, lam_init, n_ctx, lat_only):
    Bsz, N, _ = qd.shape
    L = N - n_ctx
    rows_n = L // GRID_W
    rows = jnp.repeat(jnp.arange(rows_n), GRID_W)
    cols = jnp.tile(jnp.arange(GRID_W), rows_n)
    q = rmsnorm(qd.reshape(Bsz, N, DA_HEADS, 2, DA_DQK), qn_g)
    k = rmsnorm(kd.reshape(Bsz, N, DA_HEADS, 2, DA_DQK), kn_g)
    q = jnp.concatenate([q[:, :n_ctx], rope_2d(q[:, n_ctx:], rows, cols)], 1).transpose(0, 2, 1, 3, 4)
    k = jnp.concatenate([k[:, :n_ctx], rope_2d(k[:, n_ctx:], rows, cols)], 1).transpose(0, 2, 1, 3, 4)
    v = vd.reshape(Bsz, N, DA_HEADS, DA_DV).transpose(0, 2, 1, 3)
    lam = (jnp.exp(jnp.sum(lq1.astype(F32) * lk1.astype(F32)))
           - jnp.exp(jnp.sum(lq2.astype(F32) * lk2.astype(F32))) + lam_init)
    nb = L // DA_QBLOCK
    qb = jnp.moveaxis(q[:, :, n_ctx:].reshape(Bsz, DA_HEADS, nb, DA_QBLOCK, 2, DA_DQK), 2, 0)
    o = lax.map(lambda qq: diff_attn(qq, k, v, lam), qb)
    o = jnp.moveaxis(o, 0, 2).reshape(Bsz, DA_HEADS, L, DA_DV)
    if not lat_only:
        o_ctx = diff_attn(q[:, :, :n_ctx], k[:, :, :n_ctx], v[:, :, :n_ctx], lam)
        o = jnp.concatenate([o_ctx, o], 2)
    o = rmsnorm(o, sub_g) * (1.0 - lam_init)
    return o.transpose(0, 2, 1, 3).reshape(Bsz, o.shape[2], DA_HEADS * DA_DV)


def moe(h, router_w, router_b, w_gate, w_up, w_down):
    Bsz, n, _ = h.shape
    score = jax.nn.sigmoid(jnp.einsum('bnd,de->bne', h, router_w).astype(F32))
    sel = score + router_b.astype(F32)
    gscore = lax.top_k(sel.reshape(Bsz, n, N_EXPERT_GROUPS, EXPERTS_PER_GROUP), 2)[0].sum(-1)
    gidx = jnp.argmax(gscore, -1)
    in_group = (jnp.arange(N_EXPERTS) // EXPERTS_PER_GROUP) == gidx[..., None]
    _, eidx = lax.top_k(jnp.where(in_group, sel, -jnp.inf), TOP_K)
    w = jnp.take_along_axis(score, eidx, -1)
    w = w / w.sum(-1, keepdims=True)
    gates = jnp.einsum('bnke,bnk->bne', jax.nn.one_hot(eidx, N_EXPERTS, dtype=F32), w).astype(h.dtype)

    def per_sample(args):
        hs, gs = args
        act = jax.nn.silu(jnp.einsum('nd,edf->nef', hs, w_gate)) * jnp.einsum('nd,edf->nef', hs, w_up)
        return jnp.einsum('nef,efd->nd', act * gs[..., None], w_down)

    return lax.map(per_sample, (h, gates))


def per_token(p_ctx, p_lat, n_ctx, n_lat, with_ctx):
    Bsz, d = p_lat.shape
    lat = jnp.broadcast_to(p_lat[:, None, :], (Bsz, n_lat, d))
    if not with_ctx:
        return lat
    return jnp.concatenate([jnp.broadcast_to(p_ctx, (Bsz, n_ctx, d)), lat], 1)


def setup_inputs(seed: int = 0) -> dict:
    key = jax.random.key(seed)
    ks = iter(jax.random.split(key, 48))

    def nrm(shape, s):
        return jax.random.normal(next(ks), shape, F32) * s

    def gain(shape):
        return 1.0 + nrm(shape, 0.02)

    D = D_MODEL
    G, P, I = S5_GROUPS, S5_STATE, S5_GROUP
    gates_off = 4 * MIX_W
    f_bias = jnp.linspace(3.0, 6.0, ML_HEADS, dtype=F32)
    b_in = nrm((DEPTH, IN_COLS), 0.02)
    b_in = b_in.at[:, gates_off + ML_HEADS:gates_off + 2 * ML_HEADS].add(f_bias)
    b_in = b_in.at[:, gates_off + 3 * ML_HEADS:gates_off + 4 * ML_HEADS].add(f_bias)
    return {
        "x": nrm((BATCH, SEQ, D), 1.0),
        "c": nrm((BATCH, D), 1.0),
        "ctx": nrm((BATCH, CTX_LEN, D), 1.0),
        "c_ctx": nrm((D,), 1.0),
        "norm1_g": gain((DEPTH, D)),
        "norm2_g": gain((DEPTH, D)),
        "ada_w": nrm((DEPTH, D, 6 * D), 0.5 * D ** -0.5),
        "ada_b": nrm((DEPTH, 6 * D), 0.02),
        "w_in": nrm((DEPTH, D, IN_COLS), D ** -0.5),
        "b_in": b_in,
        "ml_conv_w": nrm((DEPTH, ML_CONV, 2 * MIX_W), 0.5),
        "ml_conv_b": nrm((DEPTH, 2 * MIX_W), 0.02),
        "ml_norm_g": gain((DEPTH, MIX_W)),
        "s5_lam_re": -0.5 + nrm((DEPTH, 2, G, P), 0.01),
        "s5_lam_im": math.pi * jnp.arange(P, dtype=F32) + nrm((DEPTH, 2, G, P), 0.01),
        "s5_log_dt": jax.random.uniform(next(ks), (DEPTH, 2, G), F32, math.log(1e-3), math.log(1e-1)),
        "s5_b_re": nrm((DEPTH, 2, G, P, I), I ** -0.5),
        "s5_b_im": nrm((DEPTH, 2, G, P, I), I ** -0.5),
        "s5_c_re": nrm((DEPTH, G, I, P), 1.0),
        "s5_c_im": nrm((DEPTH, G, I, P), 1.0),
        "s5_d": nrm((DEPTH, MIX_W), 1.0),
        "s5_glu_w": nrm((DEPTH, MIX_W, MIX_W), MIX_W ** -0.5),
        "s5_glu_b": nrm((DEPTH, MIX_W), 0.02),
        "da_q_norm_g": gain((DEPTH, DA_DQK)),
        "da_k_norm_g": gain((DEPTH, DA_DQK)),
        "da_lam_q1": nrm((DEPTH, DA_DQK), 0.1),
        "da_lam_k1": nrm((DEPTH, DA_DQK), 0.1),
        "da_lam_q2": nrm((DEPTH, DA_DQK), 0.1),
        "da_lam_k2": nrm((DEPTH, DA_DQK), 0.1),
        "da_sub_norm_g": gain((DEPTH, DA_DV)),
        "branch_proj": nrm((DEPTH, N_BRANCH, MIX_W, D), MIX_W ** -0.5),
        "w_out": nrm((DEPTH, D, D), D ** -0.5),
        "router_w": nrm((D, N_EXPERTS), D ** -0.5),
        "router_b": nrm((N_EXPERTS,), 0.01),
        "exp_w_gate": nrm((DEPTH, N_EXPERTS, D, D_FF_EXPERT), D ** -0.5),
        "exp_w_up": nrm((DEPTH, N_EXPERTS, D, D_FF_EXPERT), D ** -0.5),
        "exp_w_down": nrm((DEPTH, N_EXPERTS, D_FF_EXPERT, D), D_FF_EXPERT ** -0.5),
    }


def reference(x, c, ctx, c_ctx, norm1_g, norm2_g, ada_w, ada_b, w_in, b_in, ml_conv_w, ml_conv_b,
              ml_norm_g, s5_lam_re, s5_lam_im, s5_log_dt, s5_b_re, s5_b_im, s5_c_re, s5_c_im, s5_d,
              s5_glu_w, s5_glu_b, da_q_norm_g, da_k_norm_g, da_lam_q1, da_lam_k1, da_lam_q2, da_lam_k2,
              da_sub_norm_g, branch_proj, w_out, router_w, router_b, exp_w_gate, exp_w_up, exp_w_down):
    n_ctx = ctx.shape[1]
    n_lat = x.shape[1]
    z = jnp.concatenate([ctx, x], 1)
    for i in range(DEPTH):
        last = i == DEPTH - 1
        lam_init = 0.8 - 0.6 * math.exp(-0.3 * i)
        mod_lat = jnp.split(jax.nn.silu(c) @ ada_w[i] + ada_b[i], 6, -1)
        mod_ctx = jnp.split(jax.nn.silu(c_ctx) @ ada_w[i] + ada_b[i], 6, -1)

        h = (rmsnorm(z, norm1_g[i]) * (1.0 + per_token(mod_ctx[1], mod_lat[1], n_ctx, n_lat, True))
             + per_token(mod_ctx[0], mod_lat[0], n_ctx, n_lat, True))
        proj = h @ w_in[i] + b_in[i]
        qa, ka, va, oa, ga, us, qd, kd, vd, gb = jnp.split(proj, IN_SPLIT_POINTS, -1)
        y_a = mlstm_branch(qa, ka, va, oa, ga, ml_conv_w[i], ml_conv_b[i], ml_norm_g[i], n_ctx)
        y_b = s5_branch(us, s5_lam_re[i], s5_lam_im[i], s5_log_dt[i], s5_b_re[i], s5_b_im[i],
                        s5_c_re[i], s5_c_im[i], s5_d[i], s5_glu_w[i], s5_glu_b[i], n_ctx)
        y_c = diff_branch(qd, kd, vd, da_q_norm_g[i], da_k_norm_g[i], da_lam_q1[i], da_lam_k1[i],
                          da_lam_q2[i], da_lam_k2[i], da_sub_norm_g[i], lam_init, n_ctx, last)
        if last:
            y_a, y_b, gb, z = y_a[:, n_ctx:], y_b[:, n_ctx:], gb[:, n_ctx:], z[:, n_ctx:]
        ys = jnp.stack([y_a, y_b, y_c], 2)
        gates = jax.nn.sigmoid(gb.reshape(gb.shape[:2] + (N_BRANCH, D_MODEL)))
        merged = jnp.einsum('bnrd,bnrd->bnd', jnp.einsum('bnrw,rwd->bnrd', ys, branch_proj[i]), gates)
        z = z + per_token(mod_ctx[2], mod_lat[2], n_ctx, n_lat, not last) * (merged @ w_out[i])

        h2 = (rmsnorm(z, norm2_g[i]) * (1.0 + per_token(mod_ctx[4], mod_lat[4], n_ctx, n_lat, not last))
              + per_token(mod_ctx[3], mod_lat[3], n_ctx, n_lat, not last))
        z = z + per_token(mod_ctx[5], mod_lat[5], n_ctx, n_lat, not last) * moe(
            h2, router_w, router_b, exp_w_gate[i], exp_w_up[i], exp_w_down[i])
    return z
```

```cpp
#include <hip/hip_runtime.h>
#include <cstdio>
#include <cstdint>
namespace pg8 {
#define PG8_LAS __attribute__((address_space(3)))
typedef unsigned short bf16_t;
typedef short bf16x8 __attribute__((ext_vector_type(8)));
typedef float f32x4 __attribute__((ext_vector_type(4)));
typedef unsigned u32x4 __attribute__((ext_vector_type(4)));
constexpr int BM = 256, BK = 64, HALF = 128, HTB = HALF * BK * 2  , STAGE_BYTES = 8 * HTB, NXCD = 8, WGM = 8;

__host__ __device__ __forceinline__ int lds_byte(int r, int c) { const int st = (r >> 4) * 2 + (c >> 5), rr = r & 15, cc = c & 31, ob = rr * 64 + cc * 2; return st * 1024 + (ob ^ (((ob >> 9) & 1) << 5)); }
__host__ __device__ __forceinline__ void stage_rc(int b, int& R, int& C) { const int st = b / 1024, sb = b % 1024, swz = sb ^ (((sb >> 9) & 1) << 5); R = (st >> 1) * 16 + swz / 64; C = (st & 1) * 32 + (swz % 64) / 2; }
__host__ __device__ __forceinline__ int perm32(int rho) { const int n = rho >> 4, i = rho & 15; return 8 * (i >> 2) + 4 * n + (i & 3); }

struct Unit { int pm, pn, pb; };
struct Gemm { const bf16_t* A; const bf16_t* Bt; int M, N, K; };

struct StaticOrder {
    int nM, nN, nwg, G, c;
    __host__ __device__ void init(int M, int N, int G_, int c_) { nM = M / BM; nN = N / BM; nwg = nM * nN; G = G_; c = c_; }
    __host__ __device__ bool next(int i, Unit& u) const {
        const long L = (long)i * G + c; if (L >= nwg) return false;
        int wgid = (int)L; { const int q = nwg / NXCD, r = nwg % NXCD, xcd = wgid % NXCD, off = wgid / NXCD; wgid = (xcd < r ? xcd * (q + 1) : r * (q + 1) + (xcd - r) * q) + off; }
        const int nig = WGM * nN, gid = wgid / nig, fm = gid * WGM, gsz = (nM - fm) < WGM ? (nM - fm) : WGM;
        u.pm = fm + ((wgid % nig) % gsz); u.pn = (wgid % nig) / gsz; u.pb = u.pn; return true;
    }
    __device__ __forceinline__ void a_ready(const Unit&) const {}
    __device__ __forceinline__ void done(const Unit&) const {}
};

__device__ __forceinline__ unsigned cvt_pk_bf16(float lo, float hi) { unsigned r; asm volatile("v_cvt_pk_bf16_f32 %0, %1, %2" : "=v"(r) : "v"(lo), "v"(hi)); return r; }
template <class Epi, class Sched, bool ALIGN_EPI = false, bool SP2 = false>
__device__ __forceinline__ void gemm_phase(PG8_LAS unsigned char* lds, const Gemm g, const Sched& S, const Epi& E) {
    const int tid = threadIdx.x, wid = __builtin_amdgcn_readfirstlane(tid >> 6), lane = tid & 63, wr = wid >> 2, wc = wid & 3, fr = lane & 15, fq = lane >> 4;
    const int K = g.K, nt = K / BK;
    unsigned voffA[2], voffB[2];
#pragma unroll
    for (int i = 0; i < 2; ++i) { int R, C; stage_rc(tid * 16 + i * 8192, R, C); const int Rb = Epi::PERM ? ((R & ~31) + perm32(R & 31)) : R;
        voffA[i] = (unsigned)(R * K + C) * 2u; voffB[i] = (unsigned)(Rb * K + C) * 2u; }
    const size_t kstep = (size_t)(BK * 2);
    const size_t hstep = (size_t)HALF * K * 2;
    const size_t tstep = 2 * hstep;
    const unsigned ldsw = (unsigned)wid * 1024u;
    const int aoff = lds_byte(wr * 64 + fr, fq * 8), boff = lds_byte(wc * 32 + fr, fq * 8);
#define PG8_SA(b, h) (((b) * 2 + (h)) * HTB)
#define PG8_SB(b, h) ((4 + (b) * 2 + (h)) * HTB)
#define PG8_STAGE(bufoff, gbase, voff) do { _Pragma("unroll") for (int _i = 0; _i < 2; ++_i) \
        __builtin_amdgcn_global_load_lds((const unsigned*)((const char*)(gbase) + (voff)[_i]), (PG8_LAS unsigned*)(lds + (bufoff) + ldsw + _i * 8192), 16, 0, 0); } while (0)
#define PG8_LDA(dst, b, h) do { _Pragma("unroll") for (int m = 0; m < 4; ++m) _Pragma("unroll") for (int k = 0; k < 2; ++k) dst[m][k] = *(const PG8_LAS bf16x8*)(lds + PG8_SA(b, h) + aoff + m * 2048 + k * 1024); } while (0)
#define PG8_LDB(dst, b, h) do { _Pragma("unroll") for (int n = 0; n < 2; ++n) _Pragma("unroll") for (int k = 0; k < 2; ++k) dst[n][k] = *(const PG8_LAS bf16x8*)(lds + PG8_SB(b, h) + boff + n * 2048 + k * 1024); } while (0)
#define PG8_MMA(ai, bj, At, Bt) do { __builtin_amdgcn_s_setprio(1); _Pragma("unroll") for (int m = 0; m < 4; ++m) _Pragma("unroll") for (int n = 0; n < 2; ++n) _Pragma("unroll") for (int k = 0; k < 2; ++k) \
        acc[ai][bj][m][n] = __builtin_amdgcn_mfma_f32_16x16x32_bf16(Bt[n][k], At[m][k], acc[ai][bj][m][n], 0, 0, 0); __builtin_amdgcn_s_setprio(0); } while (0)
#define PG8_WAIT_V(n) asm volatile("s_waitcnt vmcnt(" #n ")" ::: "memory")
#define PG8_WAIT_L(n) asm volatile("s_waitcnt lgkmcnt(" #n ")" ::: "memory")
#define PG8_BAR __builtin_amdgcn_s_barrier()
#define PG8_SCHED __builtin_amdgcn_sched_barrier(0)
    Unit cur, nxt; int ui = 0;
    if (!S.next(0, cur)) return;
    f32x4 acc[2][2][4][2];
#pragma unroll
    for (int a = 0; a < 2; ++a)
#pragma unroll
        for (int b = 0; b < 2; ++b)
#pragma unroll
            for (int m = 0; m < 4; ++m)
#pragma unroll
                for (int n = 0; n < 2; ++n) acc[a][b][m][n] = (f32x4){0.f, 0.f, 0.f, 0.f};
    bf16x8 At[4][2], B0[2][2], B1[2][2];
    const char* cA = (const char*)g.A + (size_t)cur.pm * tstep; const char* cB = (const char*)g.Bt + (size_t)cur.pb * tstep;
    S.a_ready(cur);
    if constexpr (SP2) {
        PG8_STAGE(PG8_SB(0, 0), cB, voffB); PG8_STAGE(PG8_SB(0, 1), cB + hstep, voffB); PG8_STAGE(PG8_SA(0, 0), cA, voffA); PG8_STAGE(PG8_SA(0, 1), cA + hstep, voffA);
        if (wr == 1) PG8_BAR;
        PG8_WAIT_V(2); PG8_BAR;
        PG8_STAGE(PG8_SB(1, 0), cB + kstep, voffB); PG8_STAGE(PG8_SA(1, 0), cA + kstep, voffA); PG8_STAGE(PG8_SB(1, 1), cB + hstep + kstep, voffB);
        PG8_WAIT_V(6); PG8_BAR;
    } else {
        PG8_STAGE(PG8_SB(0, 0), cB, voffB); PG8_STAGE(PG8_SA(0, 0), cA, voffA); PG8_STAGE(PG8_SB(0, 1), cB + hstep, voffB); PG8_STAGE(PG8_SA(0, 1), cA + hstep, voffA);
        if (wr == 1) PG8_BAR;
        PG8_WAIT_V(4); PG8_BAR;
        PG8_STAGE(PG8_SB(1, 0), cB + kstep, voffB); PG8_STAGE(PG8_SA(1, 0), cA + kstep, voffA); PG8_STAGE(PG8_SB(1, 1), cB + hstep + kstep, voffB);
        PG8_WAIT_V(6); PG8_BAR;
    }
    for (;;) {
        const bool has_next = S.next(ui + 1, nxt);
        const char* nA = has_next ? (const char*)g.A + (size_t)nxt.pm * tstep : cA; const char* nB = has_next ? (const char*)g.Bt + (size_t)nxt.pb * tstep : cB;
        for (int t = 0; t < nt; t += 2) {
            const bool last = (t == nt - 2);
            const char* a1 = cA + (size_t)(t + 1) * kstep;
            const char* a2 = last ? nA : cA + (size_t)(t + 2) * kstep; const char* b2 = last ? nB : cB + (size_t)(t + 2) * kstep;
            const char* a3 = a2 + kstep; const char* b3 = b2 + kstep;
            if (last && has_next) S.a_ready(nxt);
            if constexpr (SP2) {
            PG8_LDB(B0, 0, 0); PG8_LDB(B1, 0, 1); PG8_SCHED; PG8_LDA(At, 0, 0); PG8_STAGE(PG8_SA(1, 1), a1 + hstep, voffA);
            PG8_WAIT_V(8); PG8_WAIT_L(0); PG8_BAR; PG8_MMA(0, 0, At, B0); PG8_MMA(0, 1, At, B1); PG8_BAR; PG8_SCHED;
            PG8_LDA(At, 0, 1); PG8_STAGE(PG8_SB(0, 0), b2, voffB); PG8_STAGE(PG8_SB(0, 1), b2 + hstep, voffB); PG8_STAGE(PG8_SA(0, 0), a2, voffA);
            PG8_WAIT_V(8); PG8_WAIT_L(0); PG8_BAR; PG8_MMA(1, 0, At, B0); PG8_MMA(1, 1, At, B1); PG8_BAR; PG8_SCHED;
            PG8_LDB(B0, 1, 0); PG8_LDB(B1, 1, 1); PG8_SCHED; PG8_LDA(At, 1, 0); PG8_STAGE(PG8_SA(0, 1), a2 + hstep, voffA);
            PG8_WAIT_V(8); PG8_WAIT_L(0); PG8_BAR; PG8_MMA(0, 0, At, B0); PG8_MMA(0, 1, At, B1); PG8_BAR; PG8_SCHED;
            PG8_LDA(At, 1, 1); PG8_STAGE(PG8_SB(1, 0), b3, voffB); PG8_STAGE(PG8_SB(1, 1), b3 + hstep, voffB); PG8_STAGE(PG8_SA(1, 0), a3, voffA);
            PG8_WAIT_V(8); PG8_WAIT_L(0); PG8_BAR; PG8_MMA(1, 0, At, B0); PG8_MMA(1, 1, At, B1); PG8_BAR; PG8_SCHED;
            } else {
            PG8_LDB(B0, 0, 0); PG8_SCHED; PG8_LDA(At, 0, 0); PG8_STAGE(PG8_SA(1, 1), a1 + hstep, voffA);
            PG8_WAIT_L(8); PG8_BAR; PG8_WAIT_L(0); PG8_MMA(0, 0, At, B0); PG8_BAR; PG8_SCHED;
            PG8_LDB(B1, 0, 1); PG8_STAGE(PG8_SB(0, 0), b2, voffB);
            PG8_BAR; PG8_WAIT_L(0); PG8_MMA(0, 1, At, B1); PG8_BAR;
            PG8_LDA(At, 0, 1); PG8_STAGE(PG8_SA(0, 0), a2, voffA);
            PG8_BAR; PG8_WAIT_L(0); PG8_MMA(1, 0, At, B0); PG8_BAR; PG8_SCHED;
            PG8_STAGE(PG8_SB(0, 1), b2 + hstep, voffB);
            PG8_WAIT_V(6); PG8_BAR; PG8_MMA(1, 1, At, B1); PG8_BAR;
            PG8_LDB(B0, 1, 0); PG8_SCHED; PG8_LDA(At, 1, 0); PG8_STAGE(PG8_SA(0, 1), a2 + hstep, voffA);
            PG8_WAIT_L(8); PG8_BAR; PG8_WAIT_L(0); PG8_MMA(0, 0, At, B0); PG8_BAR; PG8_SCHED;
            PG8_LDB(B1, 1, 1); PG8_STAGE(PG8_SB(1, 0), b3, voffB);
            PG8_BAR; PG8_WAIT_L(0); PG8_MMA(0, 1, At, B1); PG8_BAR;
            PG8_LDA(At, 1, 1); PG8_STAGE(PG8_SA(1, 0), a3, voffA);
            PG8_BAR; PG8_WAIT_L(0); PG8_MMA(1, 0, At, B0); PG8_BAR; PG8_SCHED;
            PG8_STAGE(PG8_SB(1, 1), b3 + hstep, voffB);
            PG8_WAIT_V(6); PG8_BAR; PG8_MMA(1, 1, At, B1); PG8_BAR;
            }
        }
        if constexpr (ALIGN_EPI) { if (wr == 0) PG8_BAR; }
        if constexpr (!Epi::AFTER_DRAIN) { E(acc, cur, wr, wc, fr, fq); S.done(cur); }
        if (!has_next) break;
#pragma unroll
        for (int a = 0; a < 2; ++a)
#pragma unroll
            for (int b = 0; b < 2; ++b)
#pragma unroll
                for (int m = 0; m < 4; ++m)
#pragma unroll
                    for (int n = 0; n < 2; ++n) acc[a][b][m][n] = (f32x4){0.f, 0.f, 0.f, 0.f};
        cur = nxt; cA = nA; cB = nB; ++ui;
        if constexpr (ALIGN_EPI) { if (wr == 1) PG8_BAR; }
    }
    PG8_WAIT_V(0);
    if constexpr (!ALIGN_EPI) { if (wr == 0) PG8_BAR; }
    PG8_BAR;
    if constexpr (Epi::AFTER_DRAIN) { E.fused(acc, cur, wr, wc, fr, fq, lds, wid, lane); S.done(cur); }
#undef PG8_SA
#undef PG8_SB
#undef PG8_STAGE
#undef PG8_LDA
#undef PG8_LDB
#undef PG8_MMA
#undef PG8_WAIT_V
#undef PG8_WAIT_L
#undef PG8_BAR
#undef PG8_SCHED
}
}

typedef unsigned short bf16;
typedef float f32x4 __attribute__((ext_vector_type(4)));
typedef unsigned u32x4 __attribute__((ext_vector_type(4)));
typedef unsigned u32x2 __attribute__((ext_vector_type(2)));
#define LAS __attribute__((address_space(3)))
constexpr int DM = 2048, NB = 4, SEQ = 2048, DEPTH = 4, CTX = 256, NTOK = CTX + SEQ, MROWS = NB * NTOK;
constexpr int MIXW = 1024, IN_COLS = 14352, NPROJ = 14336, NPADIN = 14592;
constexpr int C_MLQ = 0, C_MLK = 1024, C_MLV = 2048, C_MLO = 3072, C_S5U = 4096, C_DAQ = 5120, C_DAK = 6144, C_DAV = 7168, C_GB = 8192;
constexpr int NEXP = 16, DFF = 512, ECAP = MROWS;
constexpr float EPS = 1e-6f;
constexpr int NT = 512;

constexpr size_t MiB = 1u << 20;
constexpr size_t al1(size_t x) { return (x + MiB - 1) / MiB * MiB; }
constexpr size_t WS_CTL = 0;
constexpr size_t WS_MOD = 1 * MiB;
constexpr size_t WS_S5P = 2 * MiB, S5P_STRIDE = 2 * MiB;
constexpr size_t WS_ROPE = 10 * MiB;
constexpr size_t WS_ROUTE = 11 * MiB;
constexpr size_t WS_GATES = 12 * MiB;
constexpr size_t WS_S5E = 13 * MiB;
constexpr size_t WS_S5C = 23 * MiB;
constexpr size_t WS_WIN = 33 * MiB;
constexpr size_t SZ_WIN = (size_t)NPADIN * DM * 2;
constexpr size_t WS_WGLU = al1(WS_WIN + DEPTH * SZ_WIN);
constexpr size_t SZ_WGLU = (size_t)MIXW * MIXW * 2;
constexpr size_t WS_WBR = al1(WS_WGLU + DEPTH * SZ_WGLU);
constexpr size_t SZ_WBR = (size_t)3 * DM * MIXW * 2;
constexpr size_t WS_WOUT = al1(WS_WBR + DEPTH * SZ_WBR);
constexpr size_t SZ_WOUT = (size_t)DM * DM * 2;
constexpr size_t WS_WGU = al1(WS_WOUT + DEPTH * SZ_WOUT);
constexpr size_t SZ_WGU = (size_t)NEXP * 2 * DFF * DM * 2;
constexpr size_t WS_WDN = al1(WS_WGU + DEPTH * SZ_WGU);
constexpr size_t SZ_WDN = (size_t)NEXP * DM * DFF * 2;
constexpr size_t WS_Z = al1(WS_WDN + DEPTH * SZ_WDN);
constexpr size_t WS_H = al1(WS_Z + (size_t)MROWS * DM * 4);
constexpr size_t WS_ACT = al1(WS_H + (size_t)MROWS * DM * 2);
constexpr size_t WS_RA = al1(WS_ACT + (size_t)NEXP * ECAP * DFF * 2);
constexpr size_t RA_PROJ = 0;
constexpr size_t RA_QK = al1(RA_PROJ + (size_t)MROWS * NPROJ * 2);
constexpr size_t RA_HML = al1(RA_QK + (size_t)MROWS * 2048 * 2);
constexpr size_t RA_YA = al1(RA_HML + (size_t)2 * MROWS * 1024 * 4);
constexpr size_t RA_YS = al1(RA_YA + (size_t)MROWS * 1024 * 2);
constexpr size_t RA_Z5 = al1(RA_YS + (size_t)2 * MROWS * 1024 * 4);
constexpr size_t RA_YB = al1(RA_Z5 + (size_t)MROWS * 1024 * 2);
constexpr size_t RA_QN = al1(RA_YB + (size_t)MROWS * 1024 * 2);
constexpr size_t RA_KN = al1(RA_QN + (size_t)MROWS * 1024 * 2);
constexpr size_t RA_YC = al1(RA_KN + (size_t)MROWS * 1024 * 2);
constexpr size_t RA_MG = al1(RA_YC + (size_t)MROWS * 1024 * 2);
constexpr size_t RA_MGB = al1(RA_MG + (size_t)MROWS * DM * 4);
constexpr size_t RA_END = al1(RA_MGB + (size_t)MROWS * DM * 2);
constexpr size_t SZ_XG = (size_t)NEXP * ECAP * DM * 2;
constexpr size_t WS_END = WS_RA + (RA_END > SZ_XG ? RA_END : SZ_XG);
static_assert(WS_END < 1940000000ull, "workspace map exceeds the guaranteed d_ws size (sum of inputs = 1.947e9 bytes)");
constexpr int CW_MOECNT = 8192;

__device__ __forceinline__ unsigned f2bf(float f) { unsigned u = __builtin_bit_cast(unsigned, f); return (u + 0x7fffu + ((u >> 16) & 1u)) >> 16; }
__device__ __forceinline__ unsigned pk2(float lo, float hi) { return f2bf(lo) | (f2bf(hi) << 16); }
__device__ __forceinline__ float bf2f(bf16 h) { return __uint_as_float(((unsigned)h) << 16); }
__device__ __forceinline__ float bflo(unsigned w) { return __uint_as_float(w << 16); }
__device__ __forceinline__ float bfhi(unsigned w) { return __uint_as_float(w & 0xffff0000u); }
__device__ __forceinline__ float wave_sum(float v) {
#pragma unroll
    for (int o = 1; o < 64; o <<= 1) v += __shfl_xor(v, o);
    return v;
}
__device__ __forceinline__ float sigmoidf_(float x) { return 1.f / (1.f + __expf(-x)); }
__device__ __forceinline__ float siluf_(float x) { return x / (1.f + __expf(-x)); }
__device__ __forceinline__ float gelu_tanh(float x) { const float u = 0.7978845608028654f * (x + 0.044715f * x * x * x); return 0.5f * x * (1.f + tanhf(u)); }
__device__ __forceinline__ float log_sigmoid(float x) { return fminf(x, 0.f) - log1pf(__expf(-fabsf(x))); }

struct P { const float* in[37]; float* out; unsigned char* ws; int layer; int pad; };
enum { I_X = 0, I_C, I_CTX, I_CCTX, I_N1G, I_N2G, I_ADAW, I_ADAB, I_WIN, I_BIN, I_MLCW, I_MLCB, I_MLNG, I_S5LR, I_S5LI, I_S5DT, I_S5BR, I_S5BI, I_S5CR, I_S5CI, I_S5D,
       I_GLUW, I_GLUB, I_DAQG, I_DAKG, I_LQ1, I_LK1, I_LQ2, I_LK2, I_SUBG, I_BRP, I_WOUT, I_RW, I_RB, I_EWG, I_EWU, I_EWD };

__device__ __forceinline__ void tr_item(const float* W, int ldw, int K, bf16* WT, int k0, int src_n0, int dst_n0, int nvalid, float* scr, int lane) {
    if (nvalid > 0) {
#pragma unroll 8
        for (int i = 0; i < 32; ++i) { const int kk = 2 * i + (lane >> 5); scr[kk * 33 + (lane & 31)] = W[(size_t)(k0 + kk) * ldw + src_n0 + (lane & 31)]; }
    }
    __builtin_amdgcn_s_waitcnt(0); asm volatile("" ::: "memory");
    const int c = lane & 7;
#pragma unroll
    for (int j = 0; j < 4; ++j) { const int n = (lane >> 3) + 8 * j; const float* s = scr + (8 * c) * 33 + n;
        u32x4 o = {0u, 0u, 0u, 0u};
        if (n < nvalid) { o.x = pk2(s[0 * 33], s[1 * 33]); o.y = pk2(s[2 * 33], s[3 * 33]); o.z = pk2(s[4 * 33], s[5 * 33]); o.w = pk2(s[6 * 33], s[7 * 33]); }
        *(u32x4*)(WT + (size_t)(dst_n0 + n) * K + k0 + 8 * c) = o; }
    __builtin_amdgcn_s_waitcnt(0); asm volatile("" ::: "memory");
}
constexpr int IT_IN = 32 * 456, IT_GLU = 16 * 32, IT_BR = 3 * 16 * 64, IT_OUT = 32 * 64, IT_G = 16 * 32 * 16, IT_U = IT_G, IT_DN = 16 * 8 * 64;
constexpr int IT_LAYER = IT_IN + IT_GLU + IT_BR + IT_OUT + IT_G + IT_U + IT_DN;
__device__ __forceinline__ void prologue_transposes(const P& p, unsigned char* lds, int bid, int nblk) {
    const int tid = threadIdx.x, wave = tid >> 6, lane = tid & 63;
    float* scr = (float*)(lds) + wave * (64 * 33);
    const int gw = bid * 8 + wave, NGW = nblk * 8;
    for (int it = gw; it < DEPTH * IT_LAYER; it += NGW) {
        const int L = it / IT_LAYER; int r = it % IT_LAYER;
        if (r < IT_IN) { const int kb = r / 456, nb = r % 456; const int dn = nb * 32;
            int sn = dn < 4096 ? dn : dn + 16, nv = 32; if (nb == 448) { sn = 4096; nv = 16; } else if (nb > 448) { sn = 0; nv = 0; }
            tr_item(p.in[I_WIN] + (size_t)L * DM * IN_COLS, IN_COLS, DM, (bf16*)(p.ws + WS_WIN + L * SZ_WIN), kb * 64, sn, dn, nv, scr, lane); continue; }
        r -= IT_IN;
        if (r < IT_GLU) { const int kb = r / 32, nb = r % 32;
            tr_item(p.in[I_GLUW] + (size_t)L * MIXW * MIXW, MIXW, MIXW, (bf16*)(p.ws + WS_WGLU + L * SZ_WGLU), kb * 64, nb * 32, nb * 32, 32, scr, lane); continue; }
        r -= IT_GLU;
        if (r < IT_BR) { const int br = r / (16 * 64), q = r % (16 * 64), kb = q / 64, nb = q % 64;
            tr_item(p.in[I_BRP] + ((size_t)L * 3 + br) * MIXW * DM, DM, MIXW, (bf16*)(p.ws + WS_WBR + L * SZ_WBR) + (size_t)br * DM * MIXW, kb * 64, nb * 32, nb * 32, 32, scr, lane); continue; }
        r -= IT_BR;
        if (r < IT_OUT) { const int kb = r / 64, nb = r % 64;
            tr_item(p.in[I_WOUT] + (size_t)L * DM * DM, DM, DM, (bf16*)(p.ws + WS_WOUT + L * SZ_WOUT), kb * 64, nb * 32, nb * 32, 32, scr, lane); continue; }
        r -= IT_OUT;
        if (r < IT_G + IT_U) { const int up = r >= IT_G; if (up) r -= IT_G; const int e = r / (32 * 16), q = r % (32 * 16), kb = q / 16, nb = q % 16; const int sn = nb * 32;
            const int dn = (sn / 128) * 256 + (sn % 128) + (up ? 128 : 0);
            tr_item(p.in[up ? I_EWU : I_EWG] + ((size_t)L * NEXP + e) * DM * DFF, DFF, DM, (bf16*)(p.ws + WS_WGU + L * SZ_WGU) + (size_t)e * 2 * DFF * DM, kb * 64, sn, dn, 32, scr, lane); continue; }
        r -= IT_G + IT_U;
        { const int e = r / (8 * 64), q = r % (8 * 64), kb = q / 64, nb = q % 64;
            tr_item(p.in[I_EWD] + ((size_t)L * NEXP + e) * DFF * DM, DM, DFF, (bf16*)(p.ws + WS_WDN + L * SZ_WDN) + (size_t)e * DM * DFF, kb * 64, nb * 32, nb * 32, 32, scr, lane); }
    }
}
__device__ __forceinline__ void prologue_ada(const P& p, unsigned char* lds, int bid, int nblk) {
    const int tid = threadIdx.x, wave = tid >> 6, lane = tid & 63;
    float* sc = (float*)lds;
    float* red = (float*)lds + 5 * DM;
    constexpr int NU = DEPTH * 96;
    if (bid >= NU) return;
    for (int i = tid; i < 5 * DM; i += NT) { const int r = i / DM, k = i % DM; const float v = r < 4 ? p.in[I_C][r * DM + k] : p.in[I_CCTX][k]; sc[i] = siluf_(v); }
    __syncthreads();
    for (int u = bid; u < NU; u += nblk) {
        const int L = u / 96, cg = u % 96;
        const float* W = p.in[I_ADAW] + (size_t)L * DM * (6 * DM) + cg * 128 + 2 * lane;
        float a0[5] = {0.f, 0.f, 0.f, 0.f, 0.f}, a1[5] = {0.f, 0.f, 0.f, 0.f, 0.f};
        const int k0 = wave * 256;
#pragma unroll 8
        for (int k = 0; k < 256; ++k) { const float2 w = *(const float2*)(W + (size_t)(k0 + k) * (6 * DM));
#pragma unroll
            for (int r = 0; r < 5; ++r) { const float s = sc[r * DM + k0 + k]; a0[r] += s * w.x; a1[r] += s * w.y; } }
#pragma unroll
        for (int r = 0; r < 5; ++r) { red[(wave * 5 + r) * 128 + 2 * lane] = a0[r]; red[(wave * 5 + r) * 128 + 2 * lane + 1] = a1[r]; }
        __syncthreads();
        for (int i = tid; i < 5 * 128; i += NT) { const int r = i / 128, c = i % 128; float s = 0.f;
#pragma unroll
            for (int w = 0; w < 8; ++w) s += red[(w * 5 + r) * 128 + c];
            const int col = cg * 128 + c;
            ((float*)(p.ws + WS_MOD))[((size_t)L * 5 + r) * (6 * DM) + col] = s + p.in[I_ADAB][L * 6 * DM + col]; }
        __syncthreads();
    }
}
__device__ __forceinline__ void prologue_small(const P& p, int bid, int nblk) {
    const int gt = bid * NT + threadIdx.x, NG = nblk * NT;
    for (int i = gt; i < DEPTH * 2 * 64 * 64; i += NG) {
        const int L = i / 8192, q = i % 8192, dg = q / 64  , pp = q % 64;
        const float lre = p.in[I_S5LR][i], lim = p.in[I_S5LI][i];
        const float dt = expf(p.in[I_S5DT][L * 128 + dg]);
        const float x = lre * dt, th = lim * dt;
        const float em1 = expm1f(x), cs = cosf(th), sn = sinf(th), sh = sinf(0.5f * th);
        const float are = (em1 + 1.f) * cs, aim = (em1 + 1.f) * sn;
        const float nr = em1 * cs - 2.f * sh * sh, ni = aim;
        const float den = lre * lre + lim * lim;
        const float fr = (nr * lre + ni * lim) / den, fi = (ni * lre - nr * lim) / den;
        float* base = (float*)(p.ws + WS_S5P + L * S5P_STRIDE);
        base[q * 2] = are; base[q * 2 + 1] = aim;
        const float m64 = expf(64.f * x); base[16384 + q * 2] = m64 * cosf(64.f * th); base[16384 + q * 2 + 1] = m64 * sinf(64.f * th);
        float* bb = base + 32768 + (size_t)q * 32;
        const float* bre = p.in[I_S5BR] + (size_t)i * 16; const float* bim = p.in[I_S5BI] + (size_t)i * 16;
#pragma unroll
        for (int k = 0; k < 16; ++k) { bb[2 * k] = fr * bre[k] - fi * bim[k]; bb[2 * k + 1] = fr * bim[k] + fi * bre[k]; }
    }
    for (int i = gt; i < 64 * 16; i += NG) { const int pos = i / 16, f = i % 16; const float fq = powf(10000.f, -(float)f / 16.f); const float ang = (float)pos * fq;
        ((float*)(p.ws + WS_ROPE))[2 * i] = cosf(ang); ((float*)(p.ws + WS_ROPE))[2 * i + 1] = sinf(ang); }
}
__global__ void __launch_bounds__(NT) k_prologue(P p) {
    extern __shared__ __attribute__((aligned(16))) unsigned char lds[];
    prologue_small(p, blockIdx.x, gridDim.x);
    prologue_ada(p, lds, blockIdx.x, gridDim.x);
    __syncthreads();
    prologue_transposes(p, lds, blockIdx.x, gridDim.x);
}

__device__ __forceinline__ int row_sel(int m) { const int b = m / NTOK, n = m % NTOK; return n < CTX ? 4 : b; }
__device__ __forceinline__ void load_z_row(const P& p, int L, int m, int lane, f32x4 (&v)[8]) {
    const int b = m / NTOK, n = m % NTOK;
    if (L == 0) {
        const float* src = n < CTX ? p.in[I_CTX] + ((size_t)b * CTX + n) * DM : p.in[I_X] + ((size_t)b * SEQ + (n - CTX)) * DM;
#pragma unroll
        for (int j = 0; j < 8; ++j) v[j] = *(const f32x4*)(src + 4 * lane + 256 * j);
    } else {
        const float* z = (const float*)(p.ws + WS_Z) + (size_t)m * DM;
        const int* rt = (const int*)(p.ws + WS_ROUTE) + (size_t)m * 8;
        const float w0 = __int_as_float(rt[2]), w1 = __int_as_float(rt[3]); const int s0 = rt[4], s1 = rt[5];
        const bf16* y0 = (const bf16*)(p.ws + WS_RA) + (size_t)s0 * DM; const bf16* y1 = (const bf16*)(p.ws + WS_RA) + (size_t)s1 * DM;
        const float* md = (const float*)(p.ws + WS_MOD) + ((size_t)(L - 1) * 5 + row_sel(m)) * (6 * DM) + 5 * DM;
#pragma unroll
        for (int j = 0; j < 8; ++j) { const int c = 4 * lane + 256 * j; const f32x4 zz = *(const f32x4*)(z + c); const f32x4 g = *(const f32x4*)(md + c);
            const u32x2 a = *(const u32x2*)(y0 + c), bq = *(const u32x2*)(y1 + c);
            f32x4 e; e.x = w0 * bflo(a.x) + w1 * bflo(bq.x); e.y = w0 * bfhi(a.x) + w1 * bfhi(bq.x); e.z = w0 * bflo(a.y) + w1 * bflo(bq.y); e.w = w0 * bfhi(a.y) + w1 * bfhi(bq.y);
            v[j] = zz + g * e; }
    }
}
__device__ __forceinline__ void phase_norm1(const P& p, int L, int bid, int nblk) {
    const int tid = threadIdx.x, wave = tid >> 6, lane = tid & 63;
    const float* g1 = p.in[I_N1G] + L * DM;
    for (int m = bid * 8 + wave; m < MROWS; m += nblk * 8) {
        f32x4 v[8]; load_z_row(p, L, m, lane, v);
        float* z = (float*)(p.ws + WS_Z) + (size_t)m * DM;
        float ss = 0.f;
#pragma unroll
        for (int j = 0; j < 8; ++j) { *(f32x4*)(z + 4 * lane + 256 * j) = v[j]; ss += v[j].x * v[j].x + v[j].y * v[j].y + v[j].z * v[j].z + v[j].w * v[j].w; }
        const float rstd = rsqrtf(wave_sum(ss) * (1.f / DM) + EPS);
        const float* md = (const float*)(p.ws + WS_MOD) + ((size_t)L * 5 + row_sel(m)) * (6 * DM);
        bf16* h = (bf16*)(p.ws + WS_H) + (size_t)m * DM;
#pragma unroll
        for (int j = 0; j < 8; ++j) { const int c = 4 * lane + 256 * j; const f32x4 g = *(const f32x4*)(g1 + c), sh = *(const f32x4*)(md + c), sc = *(const f32x4*)(md + DM + c);
            const f32x4 o = v[j] * rstd * g * (sc + 1.f) + sh; u32x2 w; w.x = pk2(o.x, o.y); w.y = pk2(o.z, o.w); *(u32x2*)(h + c) = w; }
    }
}
__global__ void __launch_bounds__(NT) k_norm1(P p) { phase_norm1(p, p.layer, blockIdx.x, gridDim.x); }
__global__ void __launch_bounds__(NT) k_final(P p) {
    const int tid = threadIdx.x, wave = tid >> 6, lane = tid & 63;
    for (int r = blockIdx.x * 8 + wave; r < NB * SEQ; r += gridDim.x * 8) {
        const int b = r / SEQ, l = r % SEQ, m = b * NTOK + CTX + l;
        f32x4 v[8]; load_z_row(p, DEPTH, m, lane, v);
        float* o = p.out + (size_t)r * DM;
#pragma unroll
        for (int j = 0; j < 8; ++j) *(f32x4*)(o + 4 * lane + 256 * j) = v[j];
    }
}

namespace pg8 {
struct EpiInproj {
    static constexpr bool PERM = true, AFTER_DRAIN = false;
    bf16_t* O; float* gates; const float* bias;
    __device__ __forceinline__ void operator()(const f32x4 (&acc)[2][2][4][2], const Unit& u, int wr, int wc, int fr, int fq) const {
        const int row0 = u.pm * BM + wr * 64 + fr;
        if (u.pn == NPROJ / 256) {
            if (wc == 0 && fq < 2) {
#pragma unroll
                for (int ai = 0; ai < 2; ++ai)
#pragma unroll
                    for (int m = 0; m < 4; ++m)
#pragma unroll
                        for (int n = 0; n < 2; ++n) { const int c = 8 * fq + 4 * n; *(f32x4*)(gates + (size_t)(row0 + ai * HALF + m * 16) * 16 + c) = acc[ai][0][m][n] + *(const f32x4*)(bias + 4096 + c); }
            }
            return;
        }
        const int col0 = u.pn * BM + wc * 32 + 8 * fq, bcol0 = col0 < 4096 ? col0 : col0 + 16;
        f32x4 bv[2][2];
#pragma unroll
        for (int bj = 0; bj < 2; ++bj)
#pragma unroll
            for (int n = 0; n < 2; ++n) bv[bj][n] = *(const f32x4*)(bias + bcol0 + bj * HALF + 4 * n);
#pragma unroll
        for (int ai = 0; ai < 2; ++ai)
#pragma unroll
            for (int m = 0; m < 4; ++m) { bf16_t* rowp = O + (size_t)(row0 + ai * HALF + m * 16) * NPROJ + col0;
#pragma unroll
                for (int bj = 0; bj < 2; ++bj) { const f32x4 v0 = acc[ai][bj][m][0] + bv[bj][0], v1 = acc[ai][bj][m][1] + bv[bj][1];
                    u32x4 w; w.x = cvt_pk_bf16(v0[0], v0[1]); w.y = cvt_pk_bf16(v0[2], v0[3]); w.z = cvt_pk_bf16(v1[0], v1[1]); w.w = cvt_pk_bf16(v1[2], v1[3]);
                    *(u32x4*)(rowp + bj * HALF) = w; } }
    }
};
struct EpiGlu {
    static constexpr bool PERM = true, AFTER_DRAIN = false;
    const bf16_t* Z5; bf16_t* O; const float* bias;
    __device__ __forceinline__ void operator()(const f32x4 (&acc)[2][2][4][2], const Unit& u, int wr, int wc, int fr, int fq) const {
        const int row0 = u.pm * BM + wr * 64 + fr, col0 = u.pn * BM + wc * 32 + 8 * fq;
#pragma unroll
        for (int ai = 0; ai < 2; ++ai)
#pragma unroll
            for (int m = 0; m < 4; ++m) { const size_t off = (size_t)(row0 + ai * HALF + m * 16) * MIXW + col0;
#pragma unroll
                for (int bj = 0; bj < 2; ++bj) { const u32x4 zz = *(const u32x4*)(Z5 + off + bj * HALF);
                    const f32x4 b0 = *(const f32x4*)(bias + col0 + bj * HALF), b1 = *(const f32x4*)(bias + col0 + bj * HALF + 4);
                    const f32x4 v0 = acc[ai][bj][m][0] + b0, v1 = acc[ai][bj][m][1] + b1;
                    u32x4 w;
                    w.x = cvt_pk_bf16(bflo(zz.x) * sigmoidf_(v0[0]), bfhi(zz.x) * sigmoidf_(v0[1])); w.y = cvt_pk_bf16(bflo(zz.y) * sigmoidf_(v0[2]), bfhi(zz.y) * sigmoidf_(v0[3]));
                    w.z = cvt_pk_bf16(bflo(zz.z) * sigmoidf_(v1[0]), bfhi(zz.z) * sigmoidf_(v1[1])); w.w = cvt_pk_bf16(bflo(zz.w) * sigmoidf_(v1[2]), bfhi(zz.w) * sigmoidf_(v1[3]));
                    *(u32x4*)(O + off + bj * HALF) = w; } }
    }
};
template <int MODE> struct EpiBranch {
    static constexpr bool PERM = true, AFTER_DRAIN = false;
    const bf16_t* GB; float* MG; bf16_t* MGB;
    __device__ __forceinline__ void operator()(const f32x4 (&acc)[2][2][4][2], const Unit& u, int wr, int wc, int fr, int fq) const {
        const int row0 = u.pm * BM + wr * 64 + fr, col0 = u.pn * BM + wc * 32 + 8 * fq;
#pragma unroll
        for (int ai = 0; ai < 2; ++ai)
#pragma unroll
            for (int m = 0; m < 4; ++m) { const size_t row = (size_t)(row0 + ai * HALF + m * 16);
#pragma unroll
                for (int bj = 0; bj < 2; ++bj) { const int c = col0 + bj * HALF; const u32x4 gg = *(const u32x4*)(GB + row * NPROJ + c);
                    f32x4 v0 = acc[ai][bj][m][0], v1 = acc[ai][bj][m][1];
                    v0[0] *= sigmoidf_(bflo(gg.x)); v0[1] *= sigmoidf_(bfhi(gg.x)); v0[2] *= sigmoidf_(bflo(gg.y)); v0[3] *= sigmoidf_(bfhi(gg.y));
                    v1[0] *= sigmoidf_(bflo(gg.z)); v1[1] *= sigmoidf_(bfhi(gg.z)); v1[2] *= sigmoidf_(bflo(gg.w)); v1[3] *= sigmoidf_(bfhi(gg.w));
                    float* mg = MG + row * DM + c;
                    if (MODE >= 1) { v0 += *(const f32x4*)mg; v1 += *(const f32x4*)(mg + 4); }
                    if (MODE <= 1) { *(f32x4*)mg = v0; *(f32x4*)(mg + 4) = v1; }
                    else { u32x4 w; w.x = cvt_pk_bf16(v0[0], v0[1]); w.y = cvt_pk_bf16(v0[2], v0[3]); w.z = cvt_pk_bf16(v1[0], v1[1]); w.w = cvt_pk_bf16(v1[2], v1[3]); *(u32x4*)(MGB + row * DM + c) = w; } } }
    }
};
struct EpiOut {
    static constexpr bool PERM = true, AFTER_DRAIN = false;
    float* Z; const float* MODL;
    __device__ __forceinline__ void operator()(const f32x4 (&acc)[2][2][4][2], const Unit& u, int wr, int wc, int fr, int fq) const {
        const int row0 = u.pm * BM + wr * 64 + fr, col0 = u.pn * BM + wc * 32 + 8 * fq;
        const int rs = row_sel(u.pm * BM);
        const float* g2 = MODL + (size_t)rs * (6 * DM) + 2 * DM;
#pragma unroll
        for (int ai = 0; ai < 2; ++ai)
#pragma unroll
            for (int m = 0; m < 4; ++m) { float* zr = Z + (size_t)(row0 + ai * HALF + m * 16) * DM;
#pragma unroll
                for (int bj = 0; bj < 2; ++bj) { const int c = col0 + bj * HALF;
                    const f32x4 ga = *(const f32x4*)(g2 + c), gb = *(const f32x4*)(g2 + c + 4);
                    *(f32x4*)(zr + c) = *(const f32x4*)(zr + c) + ga * acc[ai][bj][m][0]; *(f32x4*)(zr + c + 4) = *(const f32x4*)(zr + c + 4) + gb * acc[ai][bj][m][1]; } }
    }
};
struct EpiGateUp {
    static constexpr bool PERM = true, AFTER_DRAIN = false;
    bf16_t* ACT;
    __device__ __forceinline__ void operator()(const f32x4 (&acc)[2][2][4][2], const Unit& u, int wr, int wc, int fr, int fq) const {
        const int row0 = u.pm * BM + wr * 64 + fr, f0 = u.pn * HALF + wc * 32 + 8 * fq;
#pragma unroll
        for (int ai = 0; ai < 2; ++ai)
#pragma unroll
            for (int m = 0; m < 4; ++m) { const f32x4 g0 = acc[ai][0][m][0], g1 = acc[ai][0][m][1], u0 = acc[ai][1][m][0], u1 = acc[ai][1][m][1];
                u32x4 w; w.x = cvt_pk_bf16(siluf_(g0[0]) * u0[0], siluf_(g0[1]) * u0[1]); w.y = cvt_pk_bf16(siluf_(g0[2]) * u0[2], siluf_(g0[3]) * u0[3]);
                w.z = cvt_pk_bf16(siluf_(g1[0]) * u1[0], siluf_(g1[1]) * u1[1]); w.w = cvt_pk_bf16(siluf_(g1[2]) * u1[2], siluf_(g1[3]) * u1[3]);
                *(u32x4*)(ACT + (size_t)(row0 + ai * HALF + m * 16) * DFF + f0) = w; }
    }
};
struct EpiPlainBf16 {
    static constexpr bool PERM = true, AFTER_DRAIN = false;
    bf16_t* O; int ldc;
    __device__ __forceinline__ void operator()(const f32x4 (&acc)[2][2][4][2], const Unit& u, int wr, int wc, int fr, int fq) const {
        const int row0 = u.pm * BM + wr * 64 + fr, col0 = u.pn * BM + wc * 32 + 8 * fq;
#pragma unroll
        for (int ai = 0; ai < 2; ++ai)
#pragma unroll
            for (int m = 0; m < 4; ++m) { bf16_t* rowp = O + (size_t)(row0 + ai * HALF + m * 16) * ldc + col0;
#pragma unroll
                for (int bj = 0; bj < 2; ++bj) { const f32x4 v0 = acc[ai][bj][m][0], v1 = acc[ai][bj][m][1];
                    u32x4 w; w.x = cvt_pk_bf16(v0[0], v0[1]); w.y = cvt_pk_bf16(v0[2], v0[3]); w.z = cvt_pk_bf16(v1[0], v1[1]); w.w = cvt_pk_bf16(v1[2], v1[3]);
                    *(u32x4*)(rowp + bj * HALF) = w; } }
    }
};
struct MoeOrder {
    const int* pre;
    int ncol, G, c;
    __device__ __forceinline__ bool next(int i, Unit& u) const {
        const int L = i * G + c; const int tot = pre[16];
        if (L >= tot * ncol) return false;
        const int tg = L / ncol, pn = L % ncol; int e = 0;
#pragma unroll
        for (int k = 1; k < 16; ++k) e += (tg >= pre[k]) ? 1 : 0;
        u.pm = e * (ECAP / BM) + (tg - pre[e]); u.pn = pn; u.pb = e * ncol + pn; return true;
    }
    __device__ __forceinline__ void a_ready(const Unit&) const {}
    __device__ __forceinline__ void done(const Unit&) const {}
};
}

__device__ __forceinline__ int tok_of(int pp, int dir) { return dir == 0 ? pp : (pp < CTX ? CTX - 1 - pp : NTOK + CTX - 1 - pp); }
__device__ __forceinline__ void phase_mlconv(const P& p, int L, int bid, int nblk) {
    const int tid = threadIdx.x, wave = tid >> 6, lane = tid & 63;
    const bf16* PROJ = (const bf16*)(p.ws + WS_RA + RA_PROJ); bf16* QK = (bf16*)(p.ws + WS_RA + RA_QK);
    const float* cw = p.in[I_MLCW] + (size_t)L * 3 * 2048; const float* cb = p.in[I_MLCB] + L * 2048;
    for (int m = bid * 8 + wave; m < MROWS; m += nblk * 8) {
        const int n = m % NTOK; const bool hp = !(n == 0 || n == CTX), hn = !(n == CTX - 1 || n == NTOK - 1);
#pragma unroll
        for (int j = 0; j < 4; ++j) { const int c = 8 * lane + 512 * j;
            const u32x4 xc = *(const u32x4*)(PROJ + (size_t)m * NPROJ + c);
            u32x4 xp = {0u, 0u, 0u, 0u}, xn = {0u, 0u, 0u, 0u};
            if (hp) xp = *(const u32x4*)(PROJ + (size_t)(m - 1) * NPROJ + c);
            if (hn) xn = *(const u32x4*)(PROJ + (size_t)(m + 1) * NPROJ + c);
            float o[8];
#pragma unroll
            for (int k = 0; k < 8; ++k) { const unsigned wp = xp[k >> 1], wc = xc[k >> 1], wn = xn[k >> 1];
                const float vp = (k & 1) ? bfhi(wp) : bflo(wp), vc = (k & 1) ? bfhi(wc) : bflo(wc), vn = (k & 1) ? bfhi(wn) : bflo(wn);
                const float y = cb[c + k] + cw[c + k] * vp + cw[2048 + c + k] * vc + cw[4096 + c + k] * vn;
                o[k] = siluf_(y) * (c >= 1024 ? 0.0625f : 1.f); }
            u32x4 w; w.x = pk2(o[0], o[1]); w.y = pk2(o[2], o[3]); w.z = pk2(o[4], o[5]); w.w = pk2(o[6], o[7]);
            *(u32x4*)(QK + (size_t)m * 2048 + c) = w; }
    }
}
__device__ __forceinline__ void phase_qkprep(const P& p, int L, int bid, int nblk) {
    const int tid = threadIdx.x, wave = tid >> 6, lane = tid & 63;
    const bf16* PROJ = (const bf16*)(p.ws + WS_RA + RA_PROJ);
    const float* rope = (const float*)(p.ws + WS_ROPE);
    const int grp = lane >> 2, l4 = lane & 3;
    for (int m = bid * 8 + wave; m < MROWS; m += nblk * 8) {
        const int n = m % NTOK; const bool lat = n >= CTX; const int l = n - CTX; const int pos = (l4 < 2) ? (l >> 6) : (l & 63);
#pragma unroll
        for (int qk = 0; qk < 2; ++qk) {
            const bf16* src = PROJ + (size_t)m * NPROJ + (qk ? C_DAK : C_DAQ) + grp * 64 + l4 * 16;
            const float* g = p.in[qk ? I_DAKG : I_DAQG] + L * 64 + l4 * 16;
            bf16* dst = (bf16*)(p.ws + WS_RA + (qk ? RA_KN : RA_QN)) + (size_t)m * 1024 + grp * 64 + l4 * 16;
            const u32x4 a = *(const u32x4*)src, b = *(const u32x4*)(src + 8);
            float v[16];
#pragma unroll
            for (int k = 0; k < 4; ++k) { v[2 * k] = bflo(a[k]); v[2 * k + 1] = bfhi(a[k]); v[8 + 2 * k] = bflo(b[k]); v[8 + 2 * k + 1] = bfhi(b[k]); }
            float ss = 0.f;
#pragma unroll
            for (int k = 0; k < 16; ++k) ss += v[k] * v[k];
            ss += __shfl_xor(ss, 1); ss += __shfl_xor(ss, 2);
            const float rstd = rsqrtf(ss * (1.f / 64.f) + EPS);
#pragma unroll
            for (int k = 0; k < 16; ++k) v[k] = v[k] * rstd * g[k];
            float o[16];
#pragma unroll
            for (int k = 0; k < 16; ++k) { const float other = __shfl_xor(v[k], 1);
                float r = v[k];
                if (lat) { const float cs = rope[(pos * 16 + k) * 2], sn = rope[(pos * 16 + k) * 2 + 1];
                    r = (l4 & 1) ? (other * sn + v[k] * cs) : (v[k] * cs - other * sn); }
                o[k] = r; }
            u32x4 w0, w1; w0.x = pk2(o[0], o[1]); w0.y = pk2(o[2], o[3]); w0.z = pk2(o[4], o[5]); w0.w = pk2(o[6], o[7]);
            w1.x = pk2(o[8], o[9]); w1.y = pk2(o[10], o[11]); w1.z = pk2(o[12], o[13]); w1.w = pk2(o[14], o[15]);
            *(u32x4*)dst = w0; *(u32x4*)(dst + 8) = w1;
        }
    }
}
__global__ void __launch_bounds__(NT) k_mixprep(P p) { phase_mlconv(p, p.layer, blockIdx.x, gridDim.x); phase_qkprep(p, p.layer, blockIdx.x, gridDim.x); }

template <bool OUT> __device__ __forceinline__ void phase_s5_chunks(const P& p, int L, unsigned char* lds, int bid, int nblk) {
    const int tid = threadIdx.x, wave = tid >> 6, lane = tid & 63;
    const bf16* PROJ = (const bf16*)(p.ws + WS_RA + RA_PROJ);
    const float* S5 = (const float*)(p.ws + WS_S5P + L * S5P_STRIDE);
    float* wl = (float*)lds + wave * 4160;
    float* sre = wl, *sim = wl + 1040, *cre = wl + 2080, *cim = wl + 3120;
    for (int task = bid * 8 + wave; task < 512 * 36; task += nblk * 8) {
        const int seq = task / 36, c = task % 36, dir = seq & 1, g = (seq >> 1) & 63, b = seq >> 7;
        const int q = dir * 4096 + g * 64 + lane;
        const float are = S5[q * 2], aim = S5[q * 2 + 1];
        float bbr[16], bbi[16];
#pragma unroll
        for (int k = 0; k < 8; ++k) { const f32x4 t = *(const f32x4*)(S5 + 32768 + (size_t)q * 32 + 4 * k); bbr[2 * k] = t.x; bbi[2 * k] = t.y; bbr[2 * k + 1] = t.z; bbi[2 * k + 1] = t.w; }
        float s_re = 0.f, s_im = 0.f;
        if (OUT) { const float* cr = (const float*)(p.ws + WS_S5C) + ((size_t)task * 64 + lane) * 2; s_re = cr[0]; s_im = cr[1];
#pragma unroll
            for (int i = 0; i < 16; ++i) { cre[i * 65 + lane] = p.in[I_S5CR][(((size_t)L * 64 + g) * 16 + i) * 64 + lane]; cim[i * 65 + lane] = p.in[I_S5CI][(((size_t)L * 64 + g) * 16 + i) * 64 + lane]; } }
        for (int sub = 0; sub < 4; ++sub) {
#pragma unroll 4
            for (int j = 0; j < 16; ++j) {
                const int n = tok_of(64 * c + 16 * sub + j, dir); const size_t m = (size_t)b * NTOK + n;
                const u32x4 ua = *(const u32x4*)(PROJ + m * NPROJ + C_S5U + g * 16), ub = *(const u32x4*)(PROJ + m * NPROJ + C_S5U + g * 16 + 8);
                float br = 0.f, bi = 0.f;
#pragma unroll
                for (int k = 0; k < 4; ++k) { const float u0 = bflo(ua[k]), u1 = bfhi(ua[k]), u2 = bflo(ub[k]), u3 = bfhi(ub[k]);
                    br += u0 * bbr[2 * k] + u1 * bbr[2 * k + 1] + u2 * bbr[8 + 2 * k] + u3 * bbr[8 + 2 * k + 1];
                    bi += u0 * bbi[2 * k] + u1 * bbi[2 * k + 1] + u2 * bbi[8 + 2 * k] + u3 * bbi[8 + 2 * k + 1]; }
                const float nr = are * s_re - aim * s_im + br, ni = are * s_im + aim * s_re + bi;
                s_re = nr; s_im = ni;
                if (OUT) { sre[j * 65 + lane] = s_re; sim[j * 65 + lane] = s_im; }
            }
            if (OUT) {
                __builtin_amdgcn_s_waitcnt(0); asm volatile("" ::: "memory");
                const int t = lane >> 2, ig = lane & 3;
                float y[4] = {0.f, 0.f, 0.f, 0.f};
                for (int pp = 0; pp < 64; ++pp) { const float xr = sre[t * 65 + pp], xi = sim[t * 65 + pp];
#pragma unroll
                    for (int k = 0; k < 4; ++k) y[k] += cre[(4 * ig + k) * 65 + pp] * xr - cim[(4 * ig + k) * 65 + pp] * xi; }
                const int n = tok_of(64 * c + 16 * sub + t, dir); const size_t m = (size_t)b * NTOK + n;
                float* YS = (float*)(p.ws + WS_RA + RA_YS) + ((size_t)dir * MROWS + m) * 1024 + g * 16 + 4 * ig;
                *(f32x4*)YS = (f32x4){y[0], y[1], y[2], y[3]};
                __builtin_amdgcn_s_waitcnt(0); asm volatile("" ::: "memory");
            }
        }
        if (!OUT) { float* e = (float*)(p.ws + WS_S5E) + ((size_t)task * 64 + lane) * 2; e[0] = s_re; e[1] = s_im; }
    }
}
__device__ __forceinline__ void phase_s5_carry(const P& p, int L, int bid, int nblk) {
    const int tid = threadIdx.x, wave = tid >> 6, lane = tid & 63;
    const float* S5 = (const float*)(p.ws + WS_S5P + L * S5P_STRIDE);
    for (int seq = bid * 8 + wave; seq < 512; seq += nblk * 8) {
        const int dir = seq & 1, g = (seq >> 1) & 63; const int q = dir * 4096 + g * 64 + lane;
        const float are = S5[16384 + q * 2], aim = S5[16384 + q * 2 + 1];
        float s_re = 0.f, s_im = 0.f;
        for (int c = 0; c < 36; ++c) { const size_t o = (((size_t)seq * 36 + c) * 64 + lane) * 2;
            float* cr = (float*)(p.ws + WS_S5C) + o; cr[0] = s_re; cr[1] = s_im;
            const float* e = (const float*)(p.ws + WS_S5E) + o;
            const float nr = are * s_re - aim * s_im + e[0], ni = are * s_im + aim * s_re + e[1]; s_re = nr; s_im = ni; }
    }
}
__device__ __forceinline__ void phase_s5_post(const P& p, int L, int bid, int nblk) {
    const bf16* PROJ = (const bf16*)(p.ws + WS_RA + RA_PROJ); const float* YS = (const float*)(p.ws + WS_RA + RA_YS); bf16* Z5 = (bf16*)(p.ws + WS_RA + RA_Z5);
    const float* dsk = p.in[I_S5D] + L * 1024;
    for (int i = bid * NT + threadIdx.x; i < MROWS * 256; i += nblk * NT) { const int m = i >> 8, c = (i & 255) * 4;
        const u32x2 uu = *(const u32x2*)(PROJ + (size_t)m * NPROJ + C_S5U + c);
        const f32x4 a = *(const f32x4*)(YS + (size_t)m * 1024 + c), b = *(const f32x4*)(YS + ((size_t)MROWS + m) * 1024 + c), d = *(const f32x4*)(dsk + c);
        const float y0 = d.x * bflo(uu.x) + a.x + b.x, y1 = d.y * bfhi(uu.x) + a.y + b.y, y2 = d.z * bflo(uu.y) + a.z + b.z, y3 = d.w * bfhi(uu.y) + a.w + b.w;
        u32x2 w; w.x = pk2(gelu_tanh(y0), gelu_tanh(y1)); w.y = pk2(gelu_tanh(y2), gelu_tanh(y3)); *(u32x2*)(Z5 + (size_t)m * 1024 + c) = w; }
}
__global__ void __launch_bounds__(NT) k_s5a(P p) { extern __shared__ __attribute__((aligned(16))) unsigned char lds[]; phase_s5_chunks<false>(p, p.layer, lds, blockIdx.x, gridDim.x); }
__global__ void __launch_bounds__(NT) k_s5b(P p) { phase_s5_carry(p, p.layer, blockIdx.x, gridDim.x); }
__global__ void __launch_bounds__(NT) k_s5c(P p) { extern __shared__ __attribute__((aligned(16))) unsigned char lds[]; phase_s5_chunks<true>(p, p.layer, lds, blockIdx.x, gridDim.x); }
__global__ void __launch_bounds__(NT) k_s5post(P p) { phase_s5_post(p, p.layer, blockIdx.x, gridDim.x); }

__device__ __forceinline__ void phase_mlstm(const P& p, int L, unsigned char* lds, int bid, int nblk) {
    const int tid = threadIdx.x, wave = tid >> 6, lane = tid & 63;
    const bf16* PROJ = (const bf16*)(p.ws + WS_RA + RA_PROJ); const bf16* QK = (const bf16*)(p.ws + WS_RA + RA_QK);
    const float* GATES = (const float*)(p.ws + WS_GATES); float* HML = (float*)(p.ws + WS_RA + RA_HML);
    unsigned* qs = (unsigned*)lds;
    unsigned* ks = qs + 64 * 129;
    float* Cs = (float*)(ks + 64 * 129);
    float* Ss = Cs + 32 * 257;
    float* vs = Ss + 64 * 65;
    float* ns = vs + 64 * 33;
    float* sa = ns + 256;
    float* sM = sa + 64, *swin = sa + 128, *snrm = sa + 192, *swS = sa + 256, *scal = sa + 320;
    for (int task = bid; task < 256; task += nblk) {
        const int b = task >> 6, h = (task >> 4) & 3, dir = (task >> 3) & 1, es = task & 7;
        for (int i = tid; i < 32 * 257; i += NT) Cs[i] = 0.f;
        if (tid < 256) ns[tid] = 0.f;
        if (tid == 0) { scal[0] = 1.f; scal[1] = 0.f; }
        __syncthreads();
        for (int c = 0; c < 36; ++c) {
#pragma unroll
            for (int i = 0; i < 4; ++i) { const int id = tid + NT * i, j = id >> 5, c8 = id & 31; const size_t m = (size_t)b * NTOK + tok_of(64 * c + j, dir);
                const u32x4 qq = *(const u32x4*)(QK + m * 2048 + h * 256 + c8 * 8), kk = *(const u32x4*)(QK + m * 2048 + 1024 + h * 256 + c8 * 8);
                unsigned* qd = qs + j * 129 + c8 * 4; unsigned* kd = ks + j * 129 + c8 * 4;
                qd[0] = qq.x; qd[1] = qq.y; qd[2] = qq.z; qd[3] = qq.w; kd[0] = kk.x; kd[1] = kk.y; kd[2] = kk.z; kd[3] = kk.w; }
            { const int j = tid >> 3, e4 = (tid & 7) * 4; const size_t m = (size_t)b * NTOK + tok_of(64 * c + j, dir);
                const u32x2 vv = *(const u32x2*)(PROJ + m * NPROJ + C_MLV + h * 256 + es * 32 + e4);
                vs[j * 33 + e4] = bflo(vv.x); vs[j * 33 + e4 + 1] = bfhi(vv.x); vs[j * 33 + e4 + 2] = bflo(vv.y); vs[j * 33 + e4 + 3] = bfhi(vv.y); }
            const float m_prev = scal[1];
            if (wave == 0) { const size_t m = (size_t)b * NTOK + tok_of(64 * c + lane, dir);
                const float ig = GATES[m * 16 + (2 * dir) * 4 + h], fg = GATES[m * 16 + (2 * dir + 1) * 4 + h];
                float bc = log_sigmoid(fg);
#pragma unroll
                for (int o = 1; o < 64; o <<= 1) { const float t = __shfl_up(bc, o); if (lane >= o) bc += t; }
                const float a = ig - bc; float cm = a;
#pragma unroll
                for (int o = 1; o < 64; o <<= 1) { const float t = __shfl_up(cm, o); if (lane >= o) cm = fmaxf(cm, t); }
                const float M = fmaxf(m_prev, cm); const float M63 = __shfl(M, 63), b63 = __shfl(bc, 63);
                sa[lane] = a; sM[lane] = M; swin[lane] = __expf(m_prev - M); snrm[lane] = __expf(-(bc + M)); swS[lane] = __expf(a - M63);
                if (lane == 0) { scal[2] = __expf(m_prev - M63); scal[3] = b63 + M63; } }
            __syncthreads();
            { const int t = tid >> 3, sg = tid & 7; const float Mt = sM[t];
#pragma unroll
                for (int i = 0; i < 8; ++i) { const int s = sg * 8 + i; float v = 0.f;
                    if (s <= t) { float d = 0.f; const unsigned* qr = qs + t * 129; const unsigned* kr = ks + s * 129;
#pragma unroll 8
                        for (int x = 0; x < 128; ++x) { const unsigned qa = qr[x], ka = kr[x]; d += bflo(qa) * bflo(ka) + bfhi(qa) * bfhi(ka); }
                        v = d * __expf(sa[s] - Mt); }
                    Ss[t * 65 + s] = v; } }
            __syncthreads();
            { const int t = tid >> 3, eg = tid & 7; const unsigned* qr = qs + t * 129;
                float in0 = 0.f, in1 = 0.f, in2 = 0.f, in3 = 0.f, nq = 0.f; const float* c0 = Cs + (eg * 4) * 257;
#pragma unroll 4
                for (int x = 0; x < 128; ++x) { const unsigned qa = qr[x]; const float q0 = bflo(qa), q1 = bfhi(qa);
                    in0 += c0[2 * x] * q0 + c0[2 * x + 1] * q1; in1 += c0[257 + 2 * x] * q0 + c0[257 + 2 * x + 1] * q1;
                    in2 += c0[514 + 2 * x] * q0 + c0[514 + 2 * x + 1] * q1; in3 += c0[771 + 2 * x] * q0 + c0[771 + 2 * x + 1] * q1;
                    nq += ns[2 * x] * q0 + ns[2 * x + 1] * q1; }
                float x0 = 0.f, x1 = 0.f, x2 = 0.f, x3 = 0.f, sr = 0.f;
#pragma unroll 4
                for (int s = 0; s < 64; ++s) { const float sv = Ss[t * 65 + s]; const float* vr = vs + s * 33 + eg * 4; x0 += sv * vr[0]; x1 += sv * vr[1]; x2 += sv * vr[2]; x3 += sv * vr[3]; sr += sv; }
                const float wi = swin[t]; const float den = fmaxf(fabsf(wi * nq + sr), snrm[t]); const float inv = 1.f / den;
                const size_t m = (size_t)b * NTOK + tok_of(64 * c + t, dir);
                *(f32x4*)(HML + ((size_t)dir * MROWS + m) * 1024 + h * 256 + es * 32 + eg * 4) = (f32x4){(wi * in0 + x0) * inv, (wi * in1 + x1) * inv, (wi * in2 + x2) * inv, (wi * in3 + x3) * inv}; }
            __syncthreads();
            { const float decay = scal[2]; const int e = tid >> 4, d0 = (tid & 15) * 16;
                float accv[16];
#pragma unroll
                for (int i = 0; i < 16; ++i) accv[i] = decay * Cs[e * 257 + d0 + i];
                for (int s = 0; s < 64; ++s) { const float wv = swS[s] * vs[s * 33 + e]; const unsigned* kr = ks + s * 129 + (d0 >> 1);
#pragma unroll
                    for (int i = 0; i < 8; ++i) { const unsigned ka = kr[i]; accv[2 * i] += wv * bflo(ka); accv[2 * i + 1] += wv * bfhi(ka); } }
#pragma unroll
                for (int i = 0; i < 16; ++i) Cs[e * 257 + d0 + i] = accv[i];
                if (tid < 256) { float nn = decay * ns[tid];
                    for (int s = 0; s < 64; ++s) { const unsigned ka = ks[s * 129 + (tid >> 1)]; nn += swS[s] * ((tid & 1) ? bfhi(ka) : bflo(ka)); }
                    ns[tid] = nn; }
                if (tid == 0) scal[1] = scal[3]; }
            __syncthreads();
        }
    }
}
__device__ __forceinline__ void phase_mlpost(const P& p, int L, int bid, int nblk) {
    const int tid = threadIdx.x, wave = tid >> 6, lane = tid & 63;
    const bf16* PROJ = (const bf16*)(p.ws + WS_RA + RA_PROJ); const float* HML = (const float*)(p.ws + WS_RA + RA_HML); bf16* YA = (bf16*)(p.ws + WS_RA + RA_YA);
    const float* ng = p.in[I_MLNG] + L * 1024;
    for (int i = bid * 8 + wave; i < MROWS * 4; i += nblk * 8) { const int m = i >> 2, h = i & 3, c = h * 256 + 4 * lane;
        const f32x4 v = *(const f32x4*)(HML + (size_t)m * 1024 + c) + *(const f32x4*)(HML + ((size_t)MROWS + m) * 1024 + c);
        const float rstd = rsqrtf(wave_sum(v.x * v.x + v.y * v.y + v.z * v.z + v.w * v.w) * (1.f / 256.f) + EPS);
        const f32x4 g = *(const f32x4*)(ng + c); const u32x2 oo = *(const u32x2*)(PROJ + (size_t)m * NPROJ + C_MLO + c);
        u32x2 w; w.x = pk2(sigmoidf_(bflo(oo.x)) * v.x * rstd * g.x, sigmoidf_(bfhi(oo.x)) * v.y * rstd * g.y);
        w.y = pk2(sigmoidf_(bflo(oo.y)) * v.z * rstd * g.z, sigmoidf_(bfhi(oo.y)) * v.w * rstd * g.w);
        *(u32x2*)(YA + (size_t)m * 1024 + c) = w; }
}
__global__ void __launch_bounds__(NT) k_mlstm(P p) { extern __shared__ __attribute__((aligned(16))) unsigned char lds[]; phase_mlstm(p, p.layer, lds, blockIdx.x, gridDim.x); }
__global__ void __launch_bounds__(NT) k_mlpost(P p) { phase_mlpost(p, p.layer, blockIdx.x, gridDim.x); }

__device__ __forceinline__ void phase_attn(const P& p, int L, unsigned char* lds, int bid, int nblk) {
    const int tid = threadIdx.x, r = tid >> 4, sub = tid & 15;
    const bf16* PROJ = (const bf16*)(p.ws + WS_RA + RA_PROJ); const bf16* QN = (const bf16*)(p.ws + WS_RA + RA_QN); const bf16* KN = (const bf16*)(p.ws + WS_RA + RA_KN);
    bf16* YC = (bf16*)(p.ws + WS_RA + RA_YC);
    float* Qs = (float*)lds;
    float* Ks = Qs + 32 * 128;
    float* Vs = Ks + 64 * 129;
    float* Ps = Vs + 64 * 128;
    const float lam_init = 0.8f - 0.6f * expf(-0.3f * (float)L);
    float d1 = 0.f, d2 = 0.f;
    for (int k = 0; k < 64; ++k) { d1 += p.in[I_LQ1][L * 64 + k] * p.in[I_LK1][L * 64 + k]; d2 += p.in[I_LQ2][L * 64 + k] * p.in[I_LK2][L * 64 + k]; }
    const float lam = expf(d1) - expf(d2) + lam_init;
    for (int unit = bid; unit < NB * 8 * 72; unit += nblk) {
        const int b = unit / (8 * 72), h = (unit / 72) % 8, qt = unit % 72; const int n0 = qt * 32; const int nkt = n0 < CTX ? CTX / 64 : NTOK / 64;
        __syncthreads();
        for (int i = tid; i < 32 * 128; i += NT) { const int rr = i >> 7, cc = i & 127; Qs[i] = bf2f(QN[((size_t)b * NTOK + n0 + rr) * 1024 + h * 128 + cc]); }
        float mx0 = -1e30f, mx1 = -1e30f, l0 = 0.f, l1 = 0.f; float o0[8], o1[8];
#pragma unroll
        for (int i = 0; i < 8; ++i) { o0[i] = 0.f; o1[i] = 0.f; }
        for (int kt = 0; kt < nkt; ++kt) {
            __syncthreads();
            for (int i = tid; i < 64 * 128; i += NT) { const int kr = i >> 7, cc = i & 127; const size_t m = (size_t)b * NTOK + kt * 64 + kr;
                Ks[kr * 129 + cc] = bf2f(KN[m * 1024 + h * 128 + cc]); Vs[kr * 128 + cc] = bf2f(PROJ[m * NPROJ + C_DAV + h * 128 + cc]); }
            __syncthreads();
            float s0[4], s1[4];
#pragma unroll
            for (int i = 0; i < 4; ++i) { const float* kr = Ks + (sub * 4 + i) * 129; const float* qr = Qs + r * 128; float a = 0.f, c = 0.f;
                for (int d = 0; d < 64; ++d) { a += qr[d] * kr[d]; c += qr[64 + d] * kr[64 + d]; }
                s0[i] = a * 0.125f; s1[i] = c * 0.125f; }
            float t0 = fmaxf(fmaxf(s0[0], s0[1]), fmaxf(s0[2], s0[3])), t1 = fmaxf(fmaxf(s1[0], s1[1]), fmaxf(s1[2], s1[3]));
#pragma unroll
            for (int o = 1; o < 16; o <<= 1) { t0 = fmaxf(t0, __shfl_xor(t0, o)); t1 = fmaxf(t1, __shfl_xor(t1, o)); }
            const float n0m = fmaxf(mx0, t0), n1m = fmaxf(mx1, t1); const float al0 = __expf(mx0 - n0m), al1 = __expf(mx1 - n1m); mx0 = n0m; mx1 = n1m;
            float ps0 = 0.f, ps1 = 0.f;
#pragma unroll
            for (int i = 0; i < 4; ++i) { const float e0 = __expf(s0[i] - mx0), e1 = __expf(s1[i] - mx1); ps0 += e0; ps1 += e1; Ps[r * 65 + sub * 4 + i] = e0; Ps[32 * 65 + r * 65 + sub * 4 + i] = e1; }
#pragma unroll
            for (int o = 1; o < 16; o <<= 1) { ps0 += __shfl_xor(ps0, o); ps1 += __shfl_xor(ps1, o); }
            l0 = l0 * al0 + ps0; l1 = l1 * al1 + ps1;
#pragma unroll
            for (int i = 0; i < 8; ++i) { o0[i] *= al0; o1[i] *= al1; }
            __syncthreads();
            for (int k = 0; k < 64; ++k) { const float p0 = Ps[r * 65 + k], p1 = Ps[32 * 65 + r * 65 + k]; const float* vr = Vs + k * 128 + sub * 8;
#pragma unroll
                for (int i = 0; i < 8; ++i) { o0[i] += p0 * vr[i]; o1[i] += p1 * vr[i]; } }
        }
        const float i0 = 1.f / l0, i1 = lam / l1; float ov[8]; float ss = 0.f;
#pragma unroll
        for (int i = 0; i < 8; ++i) { ov[i] = o0[i] * i0 - o1[i] * i1; ss += ov[i] * ov[i]; }
#pragma unroll
        for (int o = 1; o < 16; o <<= 1) ss += __shfl_xor(ss, o);
        const float rstd = rsqrtf(ss * (1.f / 128.f) + EPS) * (1.f - lam_init);
        const float* sg = p.in[I_SUBG] + L * 128 + sub * 8;
        u32x4 w; w.x = pk2(ov[0] * rstd * sg[0], ov[1] * rstd * sg[1]); w.y = pk2(ov[2] * rstd * sg[2], ov[3] * rstd * sg[3]);
        w.z = pk2(ov[4] * rstd * sg[4], ov[5] * rstd * sg[5]); w.w = pk2(ov[6] * rstd * sg[6], ov[7] * rstd * sg[7]);
        *(u32x4*)(YC + ((size_t)b * NTOK + n0 + r) * 1024 + h * 128 + sub * 8) = w;
    }
}
__global__ void __launch_bounds__(NT) k_attn(P p) { extern __shared__ __attribute__((aligned(16))) unsigned char lds[]; phase_attn(p, p.layer, lds, blockIdx.x, gridDim.x); }

__device__ __forceinline__ void phase_norm2(const P& p, int L, int bid, int nblk) {
    const int tid = threadIdx.x, wave = tid >> 6, lane = tid & 63;
    const float* g2 = p.in[I_N2G] + L * DM; const float* rw = p.in[I_RW]; const float* rb = p.in[I_RB];
    unsigned* cnt = (unsigned*)(p.ws + WS_CTL) + CW_MOECNT + L * 64;
    bf16* XG = (bf16*)(p.ws + WS_RA);
    for (int m = bid * 8 + wave; m < MROWS; m += nblk * 8) {
        const float* z = (const float*)(p.ws + WS_Z) + (size_t)m * DM;
        f32x4 v[8]; float ss = 0.f;
#pragma unroll
        for (int j = 0; j < 8; ++j) { v[j] = *(const f32x4*)(z + 4 * lane + 256 * j); ss += v[j].x * v[j].x + v[j].y * v[j].y + v[j].z * v[j].z + v[j].w * v[j].w; }
        const float rstd = rsqrtf(wave_sum(ss) * (1.f / DM) + EPS);
        const float* md = (const float*)(p.ws + WS_MOD) + ((size_t)L * 5 + row_sel(m)) * (6 * DM);
        float lg[16];
#pragma unroll
        for (int e = 0; e < 16; ++e) lg[e] = 0.f;
#pragma unroll
        for (int j = 0; j < 8; ++j) { const int c = 4 * lane + 256 * j; const f32x4 g = *(const f32x4*)(g2 + c), sh = *(const f32x4*)(md + 3 * DM + c), sc = *(const f32x4*)(md + 4 * DM + c);
            v[j] = v[j] * rstd * g * (sc + 1.f) + sh;
#pragma unroll
            for (int k = 0; k < 4; ++k) { const float hv = v[j][k]; const float* wr = rw + (size_t)(c + k) * 16;
#pragma unroll
                for (int q = 0; q < 4; ++q) { const f32x4 w4 = *(const f32x4*)(wr + 4 * q); lg[4 * q] += hv * w4.x; lg[4 * q + 1] += hv * w4.y; lg[4 * q + 2] += hv * w4.z; lg[4 * q + 3] += hv * w4.w; } } }
        float score[16], sel[16];
#pragma unroll
        for (int e = 0; e < 16; ++e) { lg[e] = wave_sum(lg[e]); score[e] = 1.f / (1.f + expf(-lg[e])); sel[e] = score[e] + rb[e]; }
        int gi = 0; float gbest = -1e30f;
#pragma unroll
        for (int g = 0; g < 4; ++g) { const float a = sel[4 * g], b = sel[4 * g + 1], c = sel[4 * g + 2], d = sel[4 * g + 3];
            const float hi1 = fmaxf(a, b), lo1 = fminf(a, b), hi2 = fmaxf(c, d), lo2 = fminf(c, d);
            const float top = fmaxf(hi1, hi2), second = fmaxf(fminf(hi1, hi2), (hi1 >= hi2) ? lo1 : lo2);
            const float gs = top + second; if (gs > gbest) { gbest = gs; gi = g; } }
        int e0 = 0, e1 = 0; float b0 = -1e30f, b1 = -1e30f, w0 = 0.f, w1 = 0.f;
#pragma unroll
        for (int e = 0; e < 16; ++e) { const bool in = (e >> 2) == gi; const float sv = sel[e];
            if (in && sv > b0) { b1 = b0; e1 = e0; w1 = w0; b0 = sv; e0 = e; w0 = score[e]; }
            else if (in && sv > b1) { b1 = sv; e1 = e; w1 = score[e]; } }
        const float wsum = w0 + w1; w0 /= wsum; w1 /= wsum;
        unsigned p0 = 0, p1 = 0;
        if (lane == 0) { p0 = atomicAdd(cnt + e0, 1u); p1 = atomicAdd(cnt + e1, 1u); }
        p0 = __shfl(p0, 0); p1 = __shfl(p1, 0);
        const int s0 = e0 * ECAP + (int)p0, s1 = e1 * ECAP + (int)p1;
        if (lane == 0) { int* rt = (int*)(p.ws + WS_ROUTE) + (size_t)m * 8; rt[0] = e0; rt[1] = e1; rt[2] = __float_as_int(w0); rt[3] = __float_as_int(w1); rt[4] = s0; rt[5] = s1; }
#pragma unroll
        for (int j = 0; j < 8; ++j) { const int c = 4 * lane + 256 * j; u32x2 w; w.x = pk2(v[j].x, v[j].y); w.y = pk2(v[j].z, v[j].w);
            *(u32x2*)(XG + (size_t)s0 * DM + c) = w; *(u32x2*)(XG + (size_t)s1 * DM + c) = w; }
    }
}
__global__ void __launch_bounds__(NT) k_norm2(P p) { phase_norm2(p, p.layer, blockIdx.x, gridDim.x); }

#define GEMM_KERNEL_PROLOG extern __shared__ __attribute__((aligned(16))) unsigned char lds_[]; LAS unsigned char* lds = (LAS unsigned char*)lds_; const int L = p.layer; (void)L;
__global__ void __launch_bounds__(NT, 2) k_inproj(P p) { GEMM_KERNEL_PROLOG
    pg8::Gemm g{(const bf16*)(p.ws + WS_H), (const bf16*)(p.ws + WS_WIN + L * SZ_WIN), MROWS, NPADIN, DM}; pg8::StaticOrder S; S.init(MROWS, NPADIN, gridDim.x, blockIdx.x);
    pg8::EpiInproj E{(bf16*)(p.ws + WS_RA + RA_PROJ), (float*)(p.ws + WS_GATES), p.in[I_BIN] + (size_t)L * IN_COLS};
    pg8::gemm_phase<pg8::EpiInproj, pg8::StaticOrder, true, true>(lds, g, S, E); }
__global__ void __launch_bounds__(NT, 2) k_glu(P p) { GEMM_KERNEL_PROLOG
    pg8::Gemm g{(const bf16*)(p.ws + WS_RA + RA_Z5), (const bf16*)(p.ws + WS_WGLU + L * SZ_WGLU), MROWS, MIXW, MIXW}; pg8::StaticOrder S; S.init(MROWS, MIXW, gridDim.x, blockIdx.x);
    pg8::EpiGlu E{(const bf16*)(p.ws + WS_RA + RA_Z5), (bf16*)(p.ws + WS_RA + RA_YB), p.in[I_GLUB] + L * MIXW};
    pg8::gemm_phase<pg8::EpiGlu, pg8::StaticOrder, true, true>(lds, g, S, E); }
template <int R> __global__ void __launch_bounds__(NT, 2) k_branch(P p) { GEMM_KERNEL_PROLOG
    const size_t ya = R == 0 ? RA_YA : (R == 1 ? RA_YB : RA_YC);
    pg8::Gemm g{(const bf16*)(p.ws + WS_RA + ya), (const bf16*)(p.ws + WS_WBR + L * SZ_WBR) + (size_t)R * DM * MIXW, MROWS, DM, MIXW}; pg8::StaticOrder S; S.init(MROWS, DM, gridDim.x, blockIdx.x);
    pg8::EpiBranch<R> E{(const bf16*)(p.ws + WS_RA + RA_PROJ) + C_GB + R * DM, (float*)(p.ws + WS_RA + RA_MG), (bf16*)(p.ws + WS_RA + RA_MGB)};
    pg8::gemm_phase<pg8::EpiBranch<R>, pg8::StaticOrder, true, true>(lds, g, S, E); }
__global__ void __launch_bounds__(NT, 2) k_outproj(P p) { GEMM_KERNEL_PROLOG
    pg8::Gemm g{(const bf16*)(p.ws + WS_RA + RA_MGB), (const bf16*)(p.ws + WS_WOUT + L * SZ_WOUT), MROWS, DM, DM}; pg8::StaticOrder S; S.init(MROWS, DM, gridDim.x, blockIdx.x);
    pg8::EpiOut E{(float*)(p.ws + WS_Z), (const float*)(p.ws + WS_MOD) + (size_t)L * 5 * 6 * DM};
    pg8::gemm_phase<pg8::EpiOut, pg8::StaticOrder, true, true>(lds, g, S, E); }
__device__ __forceinline__ void moe_prefix(const P& p, int L, int* pre) {
    if (threadIdx.x == 0) { const unsigned* cnt = (const unsigned*)(p.ws + WS_CTL) + CW_MOECNT + L * 64; int a = 0;
        for (int e = 0; e < 16; ++e) { pre[e] = a; a += (int)((__hip_atomic_load(cnt + e, __ATOMIC_RELAXED, __HIP_MEMORY_SCOPE_AGENT) + 255u) >> 8); } pre[16] = a; }
    __syncthreads();
}
__global__ void __launch_bounds__(NT, 2) k_moe_gu(P p) { GEMM_KERNEL_PROLOG
    int* pre = (int*)(lds_ + 131072); moe_prefix(p, L, pre);
    pg8::Gemm g{(const bf16*)(p.ws + WS_RA), (const bf16*)(p.ws + WS_WGU + L * SZ_WGU), NEXP * ECAP, 2 * DFF, DM}; pg8::MoeOrder S{pre, 4, (int)gridDim.x, (int)blockIdx.x};
    pg8::EpiGateUp E{(bf16*)(p.ws + WS_ACT)};
    pg8::gemm_phase<pg8::EpiGateUp, pg8::MoeOrder, true, true>(lds, g, S, E); }
__global__ void __launch_bounds__(NT, 2) k_moe_dn(P p) { GEMM_KERNEL_PROLOG
    int* pre = (int*)(lds_ + 131072); moe_prefix(p, L, pre);
    pg8::Gemm g{(const bf16*)(p.ws + WS_ACT), (const bf16*)(p.ws + WS_WDN + L * SZ_WDN), NEXP * ECAP, DM, DFF}; pg8::MoeOrder S{pre, 8, (int)gridDim.x, (int)blockIdx.x};
    pg8::EpiPlainBf16 E{(bf16*)(p.ws + WS_RA), DM};
    pg8::gemm_phase<pg8::EpiPlainBf16, pg8::MoeOrder, true, true>(lds, g, S, E); }

constexpr int LDS_BYTES = 147456;
extern "C" void kernel_launch(void* const* d_in, const int* in_sizes, int n_in, void* d_out, int out_size, void* d_ws, size_t ws_size, hipStream_t stream) {
    static int grid = 0;
    if (grid == 0) {
        if (n_in != 37 || ws_size < WS_END || out_size != NB * SEQ * DM) { fprintf(stderr, "kernel_launch: unexpected shapes (n_in %d, ws %zu < %zu?, out %d)\n", n_in, ws_size, (size_t)WS_END, out_size); grid = -1; return; }
        int dev = 0, cus = 0; hipGetDevice(&dev); hipDeviceGetAttribute(&cus, hipDeviceAttributeMultiprocessorCount, dev);
        const void* ks[] = {(const void*)k_prologue, (const void*)k_norm1, (const void*)k_final, (const void*)k_mixprep, (const void*)k_s5a, (const void*)k_s5b, (const void*)k_s5c, (const void*)k_s5post,
            (const void*)k_mlstm, (const void*)k_mlpost, (const void*)k_attn, (const void*)k_norm2, (const void*)k_inproj, (const void*)k_glu, (const void*)k_branch<0>, (const void*)k_branch<1>, (const void*)k_branch<2>,
            (const void*)k_outproj, (const void*)k_moe_gu, (const void*)k_moe_dn};
        for (const void* k : ks) if (hipFuncSetAttribute(k, hipFuncAttributeMaxDynamicSharedMemorySize, LDS_BYTES) != hipSuccess) { fprintf(stderr, "hipFuncSetAttribute failed\n"); grid = -1; return; }
        grid = cus > 0 ? cus : 256;
    }
    if (grid < 0) return;
    hipMemsetAsync((char*)d_ws + WS_CTL, 0, 1 * MiB, stream);
    P p{}; for (int i = 0; i < 37; ++i) p.in[i] = (const float*)d_in[i]; p.out = (float*)d_out; p.ws = (unsigned char*)d_ws; p.layer = 0; p.pad = 0;
#define LAUNCH(k) hipLaunchKernelGGL(k, dim3(grid), dim3(NT), LDS_BYTES, stream, p)
    LAUNCH(k_prologue);
    for (int L = 0; L < DEPTH; ++L) {
        p.layer = L;
        LAUNCH(k_norm1); LAUNCH(k_inproj); LAUNCH(k_mixprep);
        LAUNCH(k_s5a); LAUNCH(k_s5b); LAUNCH(k_s5c); LAUNCH(k_s5post); LAUNCH(k_glu);
        LAUNCH(k_mlstm); LAUNCH(k_mlpost);
        LAUNCH(k_attn);
        LAUNCH(k_branch<0>); LAUNCH(k_branch<1>); LAUNCH(k_branch<2>); LAUNCH(k_outproj);
        LAUNCH(k_norm2); LAUNCH(k_moe_gu); LAUNCH(k_moe_dn);
    }
    LAUNCH(k_final);
    const hipError_t le = hipPeekAtLastError();
    if (le != hipSuccess) fprintf(stderr, "kernel_launch: launch failed: %s\n", hipGetErrorName(le));
}
```

```cpp
#include <hip/hip_runtime.h>
#include <cstdio>
#include <cstdint>
#ifndef PROBE_DUP
#define PROBE_DUP 0
#endif
template <class T> __device__ __forceinline__ T* lp_(T* x) { asm volatile("" : "+s"(x)); return x; }
constexpr int LDS_TIDTAB = 143360 + 1024;
constexpr int LDS_QSLOT = 143360 + 512;
__device__ __forceinline__ int tid_() {
    const unsigned key = (unsigned)__builtin_amdgcn_s_getreg((6 << 11) | 4) & 63u;
    const int wv = __builtin_amdgcn_readfirstlane(*(const __attribute__((address_space(3))) int*)(uintptr_t)(LDS_TIDTAB + key * 4));
    int t = wv * 64 + (int)__builtin_amdgcn_mbcnt_hi(~0u, __builtin_amdgcn_mbcnt_lo(~0u, 0u)); asm volatile("" : "+v"(t)); return t; }
namespace pg8 {
#define PG8_LAS __attribute__((address_space(3)))
typedef unsigned short bf16_t;
typedef short bf16x8 __attribute__((ext_vector_type(8)));
typedef float f32x4 __attribute__((ext_vector_type(4)));
typedef unsigned u32x4 __attribute__((ext_vector_type(4)));
constexpr int BM = 256, BK = 64, HALF = 128, HTB = HALF * BK * 2  , STAGE_BYTES = 8 * HTB, NXCD = 8, WGM = 8;

__host__ __device__ __forceinline__ int lds_byte(int r, int c) { const int st = (r >> 4) * 2 + (c >> 5), rr = r & 15, cc = c & 31, ob = rr * 64 + cc * 2; return st * 1024 + (ob ^ (((ob >> 9) & 1) << 5)); }
__host__ __device__ __forceinline__ void stage_rc(int b, int& R, int& C) { const int st = b / 1024, sb = b % 1024, swz = sb ^ (((sb >> 9) & 1) << 5); R = (st >> 1) * 16 + swz / 64; C = (st & 1) * 32 + (swz % 64) / 2; }
__host__ __device__ __forceinline__ int perm32(int rho) { const int n = rho >> 4, i = rho & 15; return 8 * (i >> 2) + 4 * n + (i & 3); }

struct Unit { int pm, pn, pb, pa, pr; };
struct Gemm { const bf16_t* A; const bf16_t* Bt; int M, N, K; int lda = 0; };

struct StaticOrder {
    int nM, nN, nwg, G, c, lat;
    __host__ __device__ void init(int M, int N, int G_, int c_, int lat_ = 0) { lat = lat_; nM = lat == 1 ? (M / BM) / 9 * 8 : (lat == 2 ? (M / BM) / 9 : M / BM); nN = N / BM; nwg = nM * nN; G = G_; c = c_; }
    __host__ __device__ bool next(int i, Unit& u) const {
        const long L = (long)i * G + c; if (L >= nwg) return false;
        int wgid = (int)L; { const int q = nwg / NXCD, r = nwg % NXCD, xcd = wgid % NXCD, off = wgid / NXCD; wgid = (xcd < r ? xcd * (q + 1) : r * (q + 1) + (xcd - r) * q) + off; }
        const int nig = WGM * nN, gid = wgid / nig, fm = gid * WGM, gsz = (nM - fm) < WGM ? (nM - fm) : WGM;
        u.pm = fm + ((wgid % nig) % gsz); if (lat == 1) u.pm = (u.pm >> 3) * 9 + 1 + (u.pm & 7); else if (lat == 2) u.pm = u.pm * 9; u.pn = (wgid % nig) / gsz; u.pb = u.pn; u.pa = u.pm; u.pr = 0; return true;
    }
    __device__ __forceinline__ void a_ready(const Unit&) const {}
    __device__ __forceinline__ void done(const Unit&) const {}
};

typedef __bf16 cvt_bf16x2 __attribute__((ext_vector_type(2))); typedef float cvt_f32x2 __attribute__((ext_vector_type(2)));
__device__ __forceinline__ unsigned cvt_pk_bf16(float lo, float hi) { const cvt_f32x2 f = {lo, hi}; const cvt_bf16x2 h = __builtin_convertvector(f, cvt_bf16x2); return __builtin_bit_cast(unsigned, h); }
template <class Epi, class Sched, bool ALIGN_EPI = false, bool SP2 = false>
__device__ __forceinline__ void gemm_phase(PG8_LAS unsigned char* lds, const Gemm g, const Sched& S, const Epi& E) {
    const int tid = tid_(), wid = __builtin_amdgcn_readfirstlane(tid >> 6), lane = tid & 63, wr = wid >> 2, wc = wid & 3, fr = lane & 15, fq = lane >> 4;
    const int K = g.K, nt = K / BK, lda = g.lda ? g.lda : g.K;
    unsigned voffA[2], voffB[2];
#pragma unroll
    for (int i = 0; i < 2; ++i) { int R, C; stage_rc(tid * 16 + i * 8192, R, C); const int Rb = Epi::PERM ? ((R & ~31) + perm32(R & 31)) : R;
        voffA[i] = (unsigned)(R * lda + C) * 2u; voffB[i] = (unsigned)(Rb * K + C) * 2u; }
    const size_t kstep = (size_t)(BK * 2);
    const size_t hstep = (size_t)HALF * K * 2;
    const size_t tstep = 2 * hstep;
    const size_t hstepA = (size_t)HALF * lda * 2, tstepA = 2 * hstepA;
    const unsigned ldsw = (unsigned)wid * 1024u;
    const int aoff = lds_byte(wr * 64 + fr, fq * 8), boff = lds_byte(wc * 32 + fr, fq * 8);
#define PG8_SA(b, h) (((b) * 2 + (h)) * HTB)
#define PG8_SB(b, h) ((4 + (b) * 2 + (h)) * HTB)
#define PG8_STAGE(bufoff, gbase, voff) do { _Pragma("unroll") for (int _i = 0; _i < 2; ++_i) \
        __builtin_amdgcn_global_load_lds((const unsigned*)((const char*)(gbase) + (voff)[_i]), (PG8_LAS unsigned*)(lds + (bufoff) + ldsw + _i * 8192), 16, 0, 0); } while (0)
#define PG8_LDA(dst, b, h) do { _Pragma("unroll") for (int m = 0; m < 4; ++m) _Pragma("unroll") for (int k = 0; k < 2; ++k) dst[m][k] = *(const PG8_LAS bf16x8*)(lds + PG8_SA(b, h) + aoff + m * 2048 + k * 1024); } while (0)
#define PG8_LDB(dst, b, h) do { _Pragma("unroll") for (int n = 0; n < 2; ++n) _Pragma("unroll") for (int k = 0; k < 2; ++k) dst[n][k] = *(const PG8_LAS bf16x8*)(lds + PG8_SB(b, h) + boff + n * 2048 + k * 1024); } while (0)
#define PG8_MMA(ai, bj, At, Bt) do { __builtin_amdgcn_s_setprio(1); _Pragma("unroll") for (int m = 0; m < 4; ++m) _Pragma("unroll") for (int n = 0; n < 2; ++n) _Pragma("unroll") for (int k = 0; k < 2; ++k) \
        acc[ai][bj][m][n] = __builtin_amdgcn_mfma_f32_16x16x32_bf16(Bt[n][k], At[m][k], acc[ai][bj][m][n], 0, 0, 0); __builtin_amdgcn_s_setprio(0); } while (0)
#define PG8_WAIT_V(n) asm volatile("s_waitcnt vmcnt(" #n ")" ::: "memory")
#define PG8_WAIT_L(n) asm volatile("s_waitcnt lgkmcnt(" #n ")" ::: "memory")
#define PG8_BAR __builtin_amdgcn_s_barrier()
#define PG8_SCHED __builtin_amdgcn_sched_barrier(0)
    Unit cur, nxt; int ui = 0;
    if (!S.next(0, cur)) return;
    f32x4 acc[2][2][4][2];
#pragma unroll
    for (int a = 0; a < 2; ++a)
#pragma unroll
        for (int b = 0; b < 2; ++b)
#pragma unroll
            for (int m = 0; m < 4; ++m)
#pragma unroll
                for (int n = 0; n < 2; ++n) acc[a][b][m][n] = (f32x4){0.f, 0.f, 0.f, 0.f};
    bf16x8 At[4][2], B0[2][2], B1[2][2];
    const char* cA = (const char*)g.A + (size_t)cur.pa * tstepA; const char* cB = (const char*)g.Bt + (size_t)cur.pb * tstep;
    S.a_ready(cur);
    if constexpr (SP2) {
        PG8_STAGE(PG8_SB(0, 0), cB, voffB); PG8_STAGE(PG8_SB(0, 1), cB + hstep, voffB); PG8_STAGE(PG8_SA(0, 0), cA, voffA); PG8_STAGE(PG8_SA(0, 1), cA + hstepA, voffA);
        if (wr == 1) PG8_BAR;
        PG8_WAIT_V(2); PG8_BAR;
        PG8_STAGE(PG8_SB(1, 0), cB + kstep, voffB); PG8_STAGE(PG8_SA(1, 0), cA + kstep, voffA); PG8_STAGE(PG8_SB(1, 1), cB + hstep + kstep, voffB);
        PG8_WAIT_V(6); PG8_BAR;
    } else {
        PG8_STAGE(PG8_SB(0, 0), cB, voffB); PG8_STAGE(PG8_SA(0, 0), cA, voffA); PG8_STAGE(PG8_SB(0, 1), cB + hstep, voffB); PG8_STAGE(PG8_SA(0, 1), cA + hstepA, voffA);
        if (wr == 1) PG8_BAR;
        PG8_WAIT_V(4); PG8_BAR;
        PG8_STAGE(PG8_SB(1, 0), cB + kstep, voffB); PG8_STAGE(PG8_SA(1, 0), cA + kstep, voffA); PG8_STAGE(PG8_SB(1, 1), cB + hstep + kstep, voffB);
        PG8_WAIT_V(6); PG8_BAR;
    }
    for (;;) {
        const bool has_next = S.next(ui + 1, nxt);
        const char* nA = has_next ? (const char*)g.A + (size_t)nxt.pa * tstepA : cA; const char* nB = has_next ? (const char*)g.Bt + (size_t)nxt.pb * tstep : cB;
        for (int t = 0; t < nt; t += 2) {
            const bool last = (t == nt - 2);
            const char* a1 = cA + (size_t)(t + 1) * kstep;
            const char* a2 = last ? nA : cA + (size_t)(t + 2) * kstep; const char* b2 = last ? nB : cB + (size_t)(t + 2) * kstep;
            const char* a3 = a2 + kstep; const char* b3 = b2 + kstep;
            if (last && has_next) S.a_ready(nxt);
            if constexpr (SP2) {
            PG8_LDB(B0, 0, 0); PG8_LDB(B1, 0, 1); PG8_SCHED; PG8_LDA(At, 0, 0); PG8_STAGE(PG8_SA(1, 1), a1 + hstepA, voffA);
            PG8_WAIT_V(8); PG8_WAIT_L(0); PG8_BAR; PG8_MMA(0, 0, At, B0); PG8_MMA(0, 1, At, B1); PG8_BAR; PG8_SCHED;
            PG8_LDA(At, 0, 1); PG8_STAGE(PG8_SB(0, 0), b2, voffB); PG8_STAGE(PG8_SB(0, 1), b2 + hstep, voffB); PG8_STAGE(PG8_SA(0, 0), a2, voffA);
            PG8_WAIT_V(8); PG8_WAIT_L(0); PG8_BAR; PG8_MMA(1, 0, At, B0); PG8_MMA(1, 1, At, B1); PG8_BAR; PG8_SCHED;
            PG8_LDB(B0, 1, 0); PG8_LDB(B1, 1, 1); PG8_SCHED; PG8_LDA(At, 1, 0); PG8_STAGE(PG8_SA(0, 1), a2 + hstepA, voffA);
            PG8_WAIT_V(8); PG8_WAIT_L(0); PG8_BAR; PG8_MMA(0, 0, At, B0); PG8_MMA(0, 1, At, B1); PG8_BAR; PG8_SCHED;
            PG8_LDA(At, 1, 1); PG8_STAGE(PG8_SB(1, 0), b3, voffB); PG8_STAGE(PG8_SB(1, 1), b3 + hstep, voffB); PG8_STAGE(PG8_SA(1, 0), a3, voffA);
            PG8_WAIT_V(8); PG8_WAIT_L(0); PG8_BAR; PG8_MMA(1, 0, At, B0); PG8_MMA(1, 1, At, B1); PG8_BAR; PG8_SCHED;
            } else {
            PG8_LDB(B0, 0, 0); PG8_SCHED; PG8_LDA(At, 0, 0); PG8_STAGE(PG8_SA(1, 1), a1 + hstepA, voffA);
            PG8_WAIT_L(8); PG8_BAR; PG8_WAIT_L(0); PG8_MMA(0, 0, At, B0); PG8_BAR; PG8_SCHED;
            PG8_LDB(B1, 0, 1); PG8_STAGE(PG8_SB(0, 0), b2, voffB);
            PG8_BAR; PG8_WAIT_L(0); PG8_MMA(0, 1, At, B1); PG8_BAR;
            PG8_LDA(At, 0, 1); PG8_STAGE(PG8_SA(0, 0), a2, voffA);
            PG8_BAR; PG8_WAIT_L(0); PG8_MMA(1, 0, At, B0); PG8_BAR; PG8_SCHED;
            PG8_STAGE(PG8_SB(0, 1), b2 + hstep, voffB);
            PG8_WAIT_V(6); PG8_BAR; PG8_MMA(1, 1, At, B1); PG8_BAR;
            PG8_LDB(B0, 1, 0); PG8_SCHED; PG8_LDA(At, 1, 0); PG8_STAGE(PG8_SA(0, 1), a2 + hstepA, voffA);
            PG8_WAIT_L(8); PG8_BAR; PG8_WAIT_L(0); PG8_MMA(0, 0, At, B0); PG8_BAR; PG8_SCHED;
            PG8_LDB(B1, 1, 1); PG8_STAGE(PG8_SB(1, 0), b3, voffB);
            PG8_BAR; PG8_WAIT_L(0); PG8_MMA(0, 1, At, B1); PG8_BAR;
            PG8_LDA(At, 1, 1); PG8_STAGE(PG8_SA(1, 0), a3, voffA);
            PG8_BAR; PG8_WAIT_L(0); PG8_MMA(1, 0, At, B0); PG8_BAR; PG8_SCHED;
            PG8_STAGE(PG8_SB(1, 1), b3 + hstep, voffB);
            PG8_WAIT_V(6); PG8_BAR; PG8_MMA(1, 1, At, B1); PG8_BAR;
            }
        }
        if constexpr (ALIGN_EPI) { if (wr == 0) PG8_BAR; }
        if constexpr (!Epi::AFTER_DRAIN) { int le = (int)__builtin_amdgcn_mbcnt_hi(~0u, __builtin_amdgcn_mbcnt_lo(~0u, 0u)); asm volatile("" : "+v"(le));
            E(acc, cur, wr, wc, le & 15, le >> 4); S.done(cur); }
        if (!has_next) break;
        if (!Epi::KEEP || nxt.pr == 0) {
#pragma unroll
        for (int a = 0; a < 2; ++a)
#pragma unroll
            for (int b = 0; b < 2; ++b)
#pragma unroll
                for (int m = 0; m < 4; ++m)
#pragma unroll
                    for (int n = 0; n < 2; ++n) acc[a][b][m][n] = (f32x4){0.f, 0.f, 0.f, 0.f};
        }
        cur = nxt; cA = nA; cB = nB; ++ui;
        if constexpr (ALIGN_EPI) { if (wr == 1) PG8_BAR; }
    }
    PG8_WAIT_V(0);
    if constexpr (!ALIGN_EPI) { if (wr == 0) PG8_BAR; }
    PG8_BAR;
    if constexpr (Epi::AFTER_DRAIN) { E.fused(acc, cur, wr, wc, fr, fq, lds, wid, lane); S.done(cur); }
#undef PG8_SA
#undef PG8_SB
#undef PG8_STAGE
#undef PG8_LDA
#undef PG8_LDB
#undef PG8_MMA
#undef PG8_WAIT_V
#undef PG8_WAIT_L
#undef PG8_BAR
#undef PG8_SCHED
}
}

typedef unsigned short bf16;
typedef float f32x4 __attribute__((ext_vector_type(4)));
typedef unsigned u32x4 __attribute__((ext_vector_type(4)));
typedef unsigned u32x2 __attribute__((ext_vector_type(2)));
#define LAS __attribute__((address_space(3)))
constexpr int DM = 2048, NB = 4, SEQ = 2048, DEPTH = 4, CTX = 256, NTOK = CTX + SEQ, MROWS = NB * NTOK;
constexpr int MIXW = 1024, IN_COLS = 14352, NPROJ = 14336, NPADIN = 14336;
constexpr int C_MLQ = 0, C_MLK = 1024, C_MLV = 2048, C_MLO = 3072, C_S5U = 4096, C_DAQ = 5120, C_DAK = 6144, C_DAV = 7168, C_GB = 8192;
constexpr int NEXP = 16, DFF = 512, ECAP = MROWS;
constexpr float EPS = 1e-6f;
constexpr int NT = 512;

constexpr size_t MiB = 1u << 20;
constexpr size_t al1(size_t x) { return (x + MiB - 1) / MiB * MiB; }
constexpr size_t WS_CTL = 0;
constexpr size_t WS_MOD = 1 * MiB;
constexpr size_t WS_S5P = 2 * MiB, S5P_STRIDE = 2 * MiB;
constexpr size_t WS_ROPE = 10 * MiB;
constexpr size_t WS_ROUTE = 11 * MiB;
constexpr size_t WS_GATES = 12 * MiB;
constexpr size_t WS_WG = 13 * MiB;
constexpr size_t WS_S5E = 14 * MiB;
constexpr size_t WS_S5C = 23 * MiB;
constexpr size_t WS_WIN = 33 * MiB;
constexpr size_t SZ_WIN = (size_t)NPADIN * DM * 2;
constexpr size_t WS_WGLU = al1(WS_WIN + DEPTH * SZ_WIN);
constexpr size_t SZ_WGLU = (size_t)MIXW * MIXW * 2;
constexpr size_t WS_WBR = al1(WS_WGLU + DEPTH * SZ_WGLU);
constexpr size_t SZ_WBR = (size_t)3 * DM * MIXW * 2;
constexpr size_t WS_WOUT = al1(WS_WBR + DEPTH * SZ_WBR);
constexpr size_t SZ_WOUT = (size_t)DM * DM * 2;
constexpr size_t WS_WGU = al1(WS_WOUT + DEPTH * SZ_WOUT);
constexpr size_t SZ_WGU = (size_t)NEXP * 2 * DFF * DM * 2;
constexpr size_t WS_WDN = al1(WS_WGU + DEPTH * SZ_WGU);
constexpr size_t SZ_WDN = (size_t)NEXP * DM * DFF * 2;
constexpr size_t WS_S5T1 = al1(WS_WDN + DEPTH * SZ_WDN);
constexpr size_t SZ_S5T1 = (size_t)64 * 256 * 256 * 2;
constexpr size_t WS_S5T2 = al1(WS_S5T1 + DEPTH * SZ_S5T1);
constexpr size_t SZ_S5T2 = (size_t)64 * 256 * 512 * 2;
constexpr size_t WS_Z = al1(WS_S5T2 + DEPTH * SZ_S5T2);
constexpr size_t WS_H = al1(WS_Z + (size_t)MROWS * DM * 4);
constexpr size_t WS_ACT = al1(WS_H + (size_t)MROWS * DM * 2);
constexpr size_t WS_RA = al1(WS_ACT + (size_t)NEXP * ECAP * DFF * 2);
constexpr size_t RA_PROJ = 0;
constexpr size_t RA_QK = al1(RA_PROJ + (size_t)MROWS * NPROJ * 2);
constexpr size_t RA_HML = al1(RA_QK + (size_t)MROWS * 2048 * 2);
constexpr size_t RA_YA = al1(RA_HML + (size_t)2 * MROWS * 1024 * 4);
constexpr size_t RA_YB = RA_YA + (size_t)MROWS * 1024 * 2, RA_YC = RA_YB + (size_t)MROWS * 1024 * 2;
constexpr int S5ROWS = 768;
constexpr size_t RA_S5E = al1(RA_YC + (size_t)MROWS * 1024 * 2);
constexpr size_t RA_S5A = al1(RA_S5E + (size_t)64 * S5ROWS * 256 * 4);
constexpr size_t RA_Z5 = al1(RA_S5A + (size_t)64 * S5ROWS * 512 * 2);
constexpr size_t RA_QN = al1(RA_Z5 + (size_t)MROWS * 1024 * 2);
constexpr size_t RA_KN = al1(RA_QN + (size_t)MROWS * 1024 * 2);
constexpr size_t RA_MGB = al1(RA_KN + (size_t)MROWS * 1024 * 2);
constexpr size_t RA_END = al1(RA_MGB + (size_t)MROWS * DM * 2);
constexpr size_t SZ_XG = (size_t)NEXP * ECAP * DM * 2;
constexpr size_t WS_END = WS_RA + (RA_END > SZ_XG ? RA_END : SZ_XG);
static_assert(WS_END < 1940000000ull, "workspace map exceeds the guaranteed d_ws size (sum of inputs = 1.947e9 bytes)");
constexpr int CW_ATTNQ = 7680;
constexpr int CW_MOECNT = 8192;

typedef __bf16 hbf16x2 __attribute__((ext_vector_type(2))); typedef float hf32x2 __attribute__((ext_vector_type(2)));
__device__ __forceinline__ unsigned pk2(float lo, float hi) { const hf32x2 f = {lo, hi}; const hbf16x2 h = __builtin_convertvector(f, hbf16x2); return __builtin_bit_cast(unsigned, h); }
__device__ __forceinline__ unsigned f2bf(float f) { return pk2(f, 0.f); }
__device__ __forceinline__ float bf2f(bf16 h) { return __uint_as_float(((unsigned)h) << 16); }
__device__ __forceinline__ float bflo(unsigned w) { return __uint_as_float(w << 16); }
__device__ __forceinline__ float bfhi(unsigned w) { return __uint_as_float(w & 0xffff0000u); }
template <int CTRL, int ROWMASK = 0xF> __device__ __forceinline__ float dppf(float old, float x) { return __int_as_float(__builtin_amdgcn_update_dpp(__float_as_int(old), __float_as_int(x), CTRL, ROWMASK, 0xF, false)); }
template <int K> __device__ __forceinline__ float xorl(float x) {
    if constexpr (K == 1) return dppf<0xB1>(x, x); else if constexpr (K == 2) return dppf<0x4E>(x, x); else if constexpr (K == 8) return dppf<0x128>(x, x);
    else return __int_as_float(__builtin_amdgcn_ds_swizzle(__float_as_int(x), (K << 10) | 0x1F)); }
__device__ __forceinline__ float xor32(float x, bool upper) { const auto rr = __builtin_amdgcn_permlane32_swap(__float_as_uint(x), __float_as_uint(x), false, false); return __uint_as_float(upper ? rr[0] : rr[1]); }
__device__ __forceinline__ float bperm(float x, int srclane) { return __int_as_float(__builtin_amdgcn_ds_bpermute(srclane << 2, __float_as_int(x))); }
__device__ __forceinline__ float rdlane(float x, int k) { return __int_as_float(__builtin_amdgcn_readlane(__float_as_int(x), k)); }
__device__ __forceinline__ float wave_sum(float v) {
    v += xorl<1>(v); v += xorl<2>(v); v += xorl<4>(v); v += xorl<8>(v); v += xorl<16>(v);
    const auto rr = __builtin_amdgcn_permlane32_swap(__float_as_uint(v), __float_as_uint(v), false, false); return __uint_as_float(rr[0]) + __uint_as_float(rr[1]);
}
template <bool MAX> __device__ __forceinline__ float wave_scan(float x) {
    const float ID = MAX ? -3.0e38f : 0.f;
#define SC_(CTRL, RM) { const float t = dppf<CTRL, RM>(ID, x); x = MAX ? fmaxf(x, t) : x + t; }
    SC_(0x111, 0xF) SC_(0x112, 0xF) SC_(0x114, 0xF) SC_(0x118, 0xF) SC_(0x142, 0xA) SC_(0x143, 0xC)
#undef SC_
    return x;
}
__device__ __forceinline__ float sigmoidf_(float x) { return __builtin_amdgcn_rcpf(1.f + __expf(-x)); }
__device__ __forceinline__ float siluf_(float x) { return x * __builtin_amdgcn_rcpf(1.f + __expf(-x)); }
__device__ __forceinline__ float gelu_tanh(float x) { const float u = 0.7978845608028654f * (x + 0.044715f * x * x * x); return x * __builtin_amdgcn_rcpf(1.f + __expf(-2.f * u)); }
__device__ __forceinline__ float log_sigmoid(float x) { return fminf(x, 0.f) - __logf(1.f + __expf(-fabsf(x))); }

struct P { const float* in[37]; float* out; unsigned char* ws; int layer; int pad; };
enum { I_X = 0, I_C, I_CTX, I_CCTX, I_N1G, I_N2G, I_ADAW, I_ADAB, I_WIN, I_BIN, I_MLCW, I_MLCB, I_MLNG, I_S5LR, I_S5LI, I_S5DT, I_S5BR, I_S5BI, I_S5CR, I_S5CI, I_S5D,
       I_GLUW, I_GLUB, I_DAQG, I_DAKG, I_LQ1, I_LK1, I_LQ2, I_LK2, I_SUBG, I_BRP, I_WOUT, I_RW, I_RB, I_EWG, I_EWU, I_EWD };

__device__ __forceinline__ void tr_item(const float* W, int ldw, int K, bf16* WT, int k0, int src_n0, int dst_n0, int nvalid, float* scr, int lane) {
    if (nvalid > 0) {
        f32x4 v[8]; const int ks = lane >> 3, n4 = (lane & 7) * 4;
#pragma unroll
        for (int i = 0; i < 8; ++i) v[i] = __builtin_nontemporal_load((const f32x4*)(W + (size_t)(k0 + 8 * i + ks) * ldw + src_n0 + n4));
#pragma unroll
        for (int i = 0; i < 8; ++i) { float* d = scr + (8 * i + ks) * 33 + n4; d[0] = v[i].x; d[1] = v[i].y; d[2] = v[i].z; d[3] = v[i].w; }
    }
    __builtin_amdgcn_s_waitcnt(0); asm volatile("" ::: "memory");
    const int c = lane & 7;
#pragma unroll
    for (int j = 0; j < 4; ++j) { const int n = (lane >> 3) + 8 * j; const float* s = scr + (8 * c) * 33 + n;
        u32x4 o = {0u, 0u, 0u, 0u};
        if (n < nvalid) { o.x = pk2(s[0 * 33], s[1 * 33]); o.y = pk2(s[2 * 33], s[3 * 33]); o.z = pk2(s[4 * 33], s[5 * 33]); o.w = pk2(s[6 * 33], s[7 * 33]); }
        __builtin_nontemporal_store(o, (u32x4*)(WT + (size_t)(dst_n0 + n) * K + k0 + 8 * c)); }
    __builtin_amdgcn_s_waitcnt(0); asm volatile("" ::: "memory");
}
constexpr int IT_IN = 32 * 448, IT_GLU = 16 * 32, IT_BR = 3 * 16 * 64, IT_OUT = 32 * 64, IT_G = 16 * 32 * 16, IT_U = IT_G, IT_DN = 16 * 8 * 64;
constexpr int IT_LAYER = IT_IN + IT_GLU + IT_BR + IT_OUT + IT_G + IT_U + IT_DN;
constexpr int IT_F0 = 6544, IT_F1 = IT_F0 + 27000, IT_F2 = IT_F1 + 10928;
static_assert(IT_F2 < IT_LAYER + 4096, "filler split");
constexpr int IT_FI = 3072;
constexpr int IT_SH = IT_FI + IT_F0 + IT_DN;
constexpr int IT_T = IT_FI + IT_F2;
constexpr int IT_P = DEPTH * IT_LAYER - (DEPTH - 1) * IT_T - IT_SH;
static_assert(IT_P >= IT_IN + IT_GLU && IT_P + IT_T >= IT_LAYER + IT_IN && IT_P + 2 * IT_T >= 2 * IT_LAYER + IT_IN && IT_P + 3 * IT_T >= 3 * IT_LAYER + IT_IN, "every layer's input-projection weights are converted before the layer starts");
static_assert(IT_FI + IT_F0 <= IT_G + IT_U, "the items of the input-projection and GLU tails must be gate / up weights (needed only by the later gate/up phase)");
__device__ __forceinline__ void prologue_transposes(const P& p, unsigned char* lds, int bid, int it0, int it1, int b0, int nb) { unsigned char* const ws = lp_(p.ws);
    if (bid < b0 || bid >= b0 + nb) return;
    const int tid = tid_(), wave = tid >> 6, lane = tid & 63;
    float* scr = (float*)(lds) + wave * (64 * 33);
    const int gw = (bid - b0) * 8 + wave, NGW = nb * 8;
    for (int it = it0 + gw; it < it1; it += NGW) {
        const int L = it / IT_LAYER; int r = it % IT_LAYER;
        if (r < IT_IN) { const int kb = r / 448, nb = r % 448; const int dn = nb * 32;
            int sn = dn < 4096 ? dn : dn + 16; const int nv = 32;
            if (dn >= C_DAQ && dn < C_DAV) { const int t0 = dn & 255;
                sn = (dn & ~255) + ((t0 & 127) >> 5) * 64 + (t0 >> 7) * 32 + 16; }
            tr_item(p.in[I_WIN] + (size_t)L * DM * IN_COLS, IN_COLS, DM, (bf16*)(ws + WS_WIN + L * SZ_WIN), kb * 64, sn, dn, nv, scr, lane); continue; }
        r -= IT_IN;
        if (r < IT_GLU) { const int kb = r / 32, nb = r % 32;
            tr_item(p.in[I_GLUW] + (size_t)L * MIXW * MIXW, MIXW, MIXW, (bf16*)(ws + WS_WGLU + L * SZ_WGLU), kb * 64, nb * 32, nb * 32, 32, scr, lane); continue; }
        r -= IT_GLU;
        if (r < IT_BR) { const int br = r / (16 * 64), q = r % (16 * 64), kb = q / 64, nb = q % 64;
            tr_item(p.in[I_BRP] + ((size_t)L * 3 + br) * MIXW * DM, DM, MIXW, (bf16*)(ws + WS_WBR + L * SZ_WBR) + (size_t)br * DM * MIXW, kb * 64, nb * 32, nb * 32, 32, scr, lane); continue; }
        r -= IT_BR;
        if (r < IT_OUT) { const int kb = r / 64, nb = r % 64;
            tr_item(p.in[I_WOUT] + (size_t)L * DM * DM, DM, DM, (bf16*)(ws + WS_WOUT + L * SZ_WOUT), kb * 64, nb * 32, nb * 32, 32, scr, lane); continue; }
        r -= IT_OUT;
        if (r < IT_G + IT_U) { const int up = r >= IT_G; if (up) r -= IT_G; const int e = r / (32 * 16), q = r % (32 * 16), kb = q / 16, nb = q % 16; const int sn = nb * 32;
            const int dn = (sn / 128) * 256 + (sn % 128) + (up ? 128 : 0);
            tr_item(p.in[up ? I_EWU : I_EWG] + ((size_t)L * NEXP + e) * DM * DFF, DFF, DM, (bf16*)(ws + WS_WGU + L * SZ_WGU) + (size_t)e * 2 * DFF * DM, kb * 64, sn, dn, 32, scr, lane); continue; }
        r -= IT_G + IT_U;
        { const int e = r / (8 * 64), q = r % (8 * 64), kb = q / 64, nb = q % 64;
            tr_item(p.in[I_EWD] + ((size_t)L * NEXP + e) * DFF * DM, DM, DFF, (bf16*)(ws + WS_WDN + L * SZ_WDN) + (size_t)e * DM * DFF, kb * 64, nb * 32, nb * 32, 32, scr, lane); }
    }
}
__device__ __forceinline__ void prologue_ada(const P& p, unsigned char* lds, int bid, int nblk) { unsigned char* const ws = lp_(p.ws);
    const int tid = tid_(), wave = tid >> 6, lane = tid & 63;
    float* sc = (float*)lds;
    float* red = (float*)lds + 5 * DM;
    constexpr int NU = DEPTH * 48;
    if (bid >= NU) return;
    for (int i = tid; i < 5 * DM; i += NT) { const int r = i / DM, k = i % DM; const float v = r < 4 ? p.in[I_C][r * DM + k] : p.in[I_CCTX][k]; sc[i] = siluf_(v); }
    __syncthreads();
    for (int u = bid; u < NU; u += nblk) {
        const int L = u / 48, cg = u % 48;
        const float* W = p.in[I_ADAW] + (size_t)L * DM * (6 * DM) + cg * 256 + 4 * lane;
        f32x4 a[5];
#pragma unroll
        for (int r = 0; r < 5; ++r) a[r] = (f32x4){0.f, 0.f, 0.f, 0.f};
        const int k0 = wave * 256;
#pragma unroll 8
        for (int k = 0; k < 256; ++k) { const f32x4 w = *(const f32x4*)(W + (size_t)(k0 + k) * (6 * DM));
#pragma unroll
            for (int r = 0; r < 5; ++r) a[r] += w * sc[r * DM + k0 + k]; }
#pragma unroll
        for (int r = 0; r < 5; ++r) *(f32x4*)(red + (wave * 5 + r) * 256 + 4 * lane) = a[r];
        __syncthreads();
        for (int i = tid; i < 5 * 256; i += NT) { const int r = i / 256, c = i % 256; float s = 0.f;
#pragma unroll
            for (int w = 0; w < 8; ++w) s += red[(w * 5 + r) * 256 + c];
            const int col = cg * 256 + c;
            ((float*)(ws + WS_MOD))[((size_t)L * 5 + r) * (6 * DM) + col] = s + p.in[I_ADAB][L * 6 * DM + col]; }
        __syncthreads();
    }
}
__device__ __forceinline__ void prologue_small(const P& p, int bid, int nblk) { unsigned char* const ws = lp_(p.ws);
    const int gt = bid * NT + tid_(), NG = nblk * NT;
    for (int i = gt; i < DEPTH * 2 * 64 * 64; i += NG) {
        const int L = i / 8192, q = i % 8192, dg = q / 64  , pp = q % 64;
        const float lre = p.in[I_S5LR][i], lim = p.in[I_S5LI][i];
        const float dt = expf(p.in[I_S5DT][L * 128 + dg]);
        const float x = lre * dt, th = lim * dt;
        const float em1 = expm1f(x), cs = cosf(th), sn = sinf(th), sh = sinf(0.5f * th);
        const float are = (em1 + 1.f) * cs, aim = (em1 + 1.f) * sn;
        const float nr = em1 * cs - 2.f * sh * sh, ni = aim;
        const float den = lre * lre + lim * lim;
        const float fr = (nr * lre + ni * lim) / den, fi = (ni * lre - nr * lim) / den;
        float* base = (float*)(ws + WS_S5P + L * S5P_STRIDE);
        base[q * 2] = are; base[q * 2 + 1] = aim;
        const float m16 = expf(16.f * x); base[16384 + q * 2] = m16 * cosf(16.f * th); base[16384 + q * 2 + 1] = m16 * sinf(16.f * th);
        float* bb = base + 32768 + (size_t)q * 32;
        const float* bre = p.in[I_S5BR] + (size_t)i * 16; const float* bim = p.in[I_S5BI] + (size_t)i * 16;
#pragma unroll
        for (int k = 0; k < 16; ++k) { bb[2 * k] = fr * bre[k] - fi * bim[k]; bb[2 * k + 1] = fr * bim[k] + fi * bre[k]; }
    }
    for (int i = gt; i < DEPTH * DM; i += NG) { const int L = i / DM, k = i % DM; const float* src = p.in[I_WIN] + ((size_t)L * DM + k) * IN_COLS + 4096;
        bf16* dst = (bf16*)(ws + WS_WG) + (size_t)L * 16 * DM + k;
#pragma unroll
        for (int q4 = 0; q4 < 4; ++q4) { const f32x4 w = *(const f32x4*)(src + 4 * q4);
            dst[(4 * q4 + 0) * DM] = (bf16)f2bf(w.x); dst[(4 * q4 + 1) * DM] = (bf16)f2bf(w.y); dst[(4 * q4 + 2) * DM] = (bf16)f2bf(w.z); dst[(4 * q4 + 3) * DM] = (bf16)f2bf(w.w); } }
    for (int i = gt; i < 64 * 16; i += NG) { const int pos = i / 16, f = i % 16; const float fq = powf(10000.f, -(float)f / 16.f); const float ang = (float)pos * fq;
        ((float*)(ws + WS_ROPE))[2 * i] = cosf(ang); ((float*)(ws + WS_ROPE))[2 * i + 1] = sinf(ang); }
}
__device__ __forceinline__ void phase_prologue(const P& p, unsigned char* lds, int bid, int nblk) {
    prologue_small(p, bid, nblk);
    prologue_ada(p, lds, bid, nblk);
    __syncthreads();
    if (PROBE_DUP == 11) { prologue_small(p, bid, nblk); prologue_ada(p, lds, bid, nblk); __syncthreads(); }
    prologue_transposes(p, lds, bid, 0, nblk == 256 ? IT_P : DEPTH * IT_LAYER, 0, nblk);
}

__device__ __forceinline__ int row_sel(int m) { const int b = m / NTOK, n = m % NTOK; return n < CTX ? 4 : b; }
__device__ __forceinline__ void load_z_row(const P& p, int L, int m, int lane, f32x4 (&v)[8]) {
    unsigned char* const ws = lp_(p.ws);
    const int b = m / NTOK, n = m % NTOK;
    if (L == 0) {
        const float* src = n < CTX ? p.in[I_CTX] + ((size_t)b * CTX + n) * DM : p.in[I_X] + ((size_t)b * SEQ + (n - CTX)) * DM;
#pragma unroll
        for (int j = 0; j < 8; ++j) v[j] = *(const f32x4*)(src + 4 * lane + 256 * j);
    } else {
        const bf16* z = (const bf16*)(ws + WS_Z) + (size_t)m * DM;
        const int* rt = (const int*)(ws + WS_ROUTE) + (size_t)m * 8;
        const float w0 = __int_as_float(rt[2]), w1 = __int_as_float(rt[3]); const int s0 = rt[4], s1 = rt[5];
        const bf16* y0 = (const bf16*)(ws + WS_RA) + (size_t)s0 * DM; const bf16* y1 = (const bf16*)(ws + WS_RA) + (size_t)s1 * DM;
        const float* md = (const float*)(ws + WS_MOD) + ((size_t)(L - 1) * 5 + row_sel(m)) * (6 * DM) + 5 * DM;
#pragma unroll
        for (int j = 0; j < 8; ++j) { const int c = 4 * lane + 256 * j; const u32x2 z2 = *(const u32x2*)(z + c); const f32x4 zz = {bflo(z2.x), bfhi(z2.x), bflo(z2.y), bfhi(z2.y)}; const f32x4 g = *(const f32x4*)(md + c);
            const u32x2 a = *(const u32x2*)(y0 + c), bq = *(const u32x2*)(y1 + c);
            f32x4 e; e.x = w0 * bflo(a.x) + w1 * bflo(bq.x); e.y = w0 * bfhi(a.x) + w1 * bfhi(bq.x); e.z = w0 * bflo(a.y) + w1 * bflo(bq.y); e.w = w0 * bfhi(a.y) + w1 * bfhi(bq.y);
            v[j] = zz + g * e; }
    }
}
template <bool DRY = false> __device__ __forceinline__ void phase_norm1(const P& p, int L, unsigned char* lds, int bid, int nblk) { unsigned char* const ws = lp_(p.ws);
    const int tid = tid_(), wave = tid >> 6, lane = tid & 63;
    const float* g1 = p.in[I_N1G] + L * DM;
    unsigned short* wg = (unsigned short*)lds;
    { const u32x4* wsrc = (const u32x4*)(ws + WS_WG + (size_t)L * 16 * DM * 2);
#pragma unroll
      for (int i = 0; i < 8; ++i) ((u32x4*)wg)[tid + NT * i] = wsrc[tid + NT * i];
      __syncthreads(); }
    const float gbias = p.in[I_BIN][(size_t)L * IN_COLS + 4096 + (((lane >> 5) & 1) * 8 + ((lane >> 4) & 1) * 4 + ((lane >> 3) & 1) * 2 + ((lane >> 2) & 1))];
    const int rpb = (MROWS + nblk - 1) / nblk;
    int crs = -1; f32x4 cA[8]; const float* mdB = nullptr;
    for (int m = bid * rpb + wave; m < min(MROWS, (bid + 1) * rpb); m += 8) {
        const int rs = __builtin_amdgcn_readfirstlane(row_sel(m));
        if (rs != crs) { crs = rs; const float* md = (const float*)(ws + WS_MOD) + ((size_t)L * 5 + rs) * (6 * DM);
#pragma unroll
            for (int j = 0; j < 8; ++j) { const int c = 4 * lane + 256 * j; cA[j] = *(const f32x4*)(g1 + c) * (*(const f32x4*)(md + DM + c) + 1.f); } mdB = md; }
        f32x4 v[8]; load_z_row(p, L, m, lane, v);
        bf16* z = (bf16*)(ws + (DRY ? WS_RA + RA_HML : WS_Z)) + (size_t)m * DM;
        float ss = 0.f;
#pragma unroll
        for (int j = 0; j < 8; ++j) { u32x2 zw; zw.x = pk2(v[j].x, v[j].y); zw.y = pk2(v[j].z, v[j].w); *(u32x2*)(z + 4 * lane + 256 * j) = zw; ss += v[j].x * v[j].x + v[j].y * v[j].y + v[j].z * v[j].z + v[j].w * v[j].w; }
        const float rstd = rsqrtf(wave_sum(ss) * (1.f / DM) + EPS);
        bf16* h = (bf16*)(ws + (DRY ? WS_RA + RA_QK : WS_H)) + (size_t)m * DM;
#pragma unroll
        for (int j = 0; j < 8; ++j) { const int c = 4 * lane + 256 * j;
            const f32x4 o = v[j] * rstd * cA[j] + *(const f32x4*)(mdB + c); u32x2 w; w.x = pk2(o.x, o.y); w.y = pk2(o.z, o.w); *(u32x2*)(h + c) = w; v[j] = o; }
        float ga[16];
#pragma unroll
        for (int q = 0; q < 16; ++q) { float a = 0.f;
#pragma unroll
            for (int j = 0; j < 8; ++j) { const u32x2 ww = *(const u32x2*)(wg + q * DM + 4 * lane + 256 * j); a += v[j].x * bflo(ww.x) + v[j].y * bfhi(ww.x) + v[j].z * bflo(ww.y) + v[j].w * bfhi(ww.y); }
            ga[q] = a; }
        { const bool h5 = lane & 32, h4 = lane & 16, h3 = lane & 8, h2 = lane & 4; float r8[8], r4[4], r2[2], r1;
#pragma unroll
          for (int i = 0; i < 8; ++i) { const float keep = h5 ? ga[i + 8] : ga[i], send = h5 ? ga[i] : ga[i + 8]; r8[i] = keep + xor32(send, h5); }
#pragma unroll
          for (int i = 0; i < 4; ++i) { const float keep = h4 ? r8[i + 4] : r8[i], send = h4 ? r8[i] : r8[i + 4]; r4[i] = keep + xorl<16>(send); }
#pragma unroll
          for (int i = 0; i < 2; ++i) { const float keep = h3 ? r4[i + 2] : r4[i], send = h3 ? r4[i] : r4[i + 2]; r2[i] = keep + xorl<8>(send); }
          { const float keep = h2 ? r2[1] : r2[0], send = h2 ? r2[0] : r2[1]; r1 = keep + xorl<4>(send); }
          r1 += xorl<2>(r1); r1 += xorl<1>(r1);
          if ((lane & 3) == 0) ((float*)(ws + (DRY ? WS_S5E : WS_GATES)))[(size_t)m * 16 + (lane >> 2)] = r1 + gbias; }
    }
}
__device__ __forceinline__ void phase_final(const P& p, int bid, int nblk) { unsigned char* const ws = lp_(p.ws);
    const int tid = tid_(), wave = tid >> 6, lane = tid & 63;
    for (int r = bid * 8 + wave; r < NB * SEQ; r += nblk * 8) {
        const int b = r / SEQ, l = r % SEQ, m = b * NTOK + CTX + l;
        f32x4 v[8]; load_z_row(p, DEPTH, m, lane, v);
        float* o = p.out + (size_t)r * DM;
#pragma unroll
        for (int j = 0; j < 8; ++j) *(f32x4*)(o + 4 * lane + 256 * j) = v[j];
    }
}

namespace pg8 {
struct EpiInproj {
    static constexpr bool PERM = true, AFTER_DRAIN = false, KEEP = false;
    bf16_t* O; const float* bias; bf16_t* A2; bf16_t* QN; bf16_t* KN; const float* qg; const float* kg; const float* rope; bf16_t* QKo; const float* cw; const float* cb;
    __device__ __forceinline__ void qk_tile(const f32x4 (&acc)[2][2][4][2], const Unit& u, int wr, int wc, int fr, int fq) const {
        const bool isk = u.pn >= C_DAK / BM; const int grp = (u.pn - (isk ? C_DAK : C_DAQ) / BM) * 4 + wc;
        const int row0 = u.pm * BM + wr * 64 + fr; const bool lat = (u.pm % 9) != 0; const int nb0 = (u.pm % 9) * BM - CTX + wr * 64 + fr;
        const float* gsrc = isk ? kg : qg; bf16_t* dst = isk ? KN : QN;
        const int ocol = u.pn * BM + wc * 64 + 8 * fq + 16;
        f32x4 bv[2][2], gv[2][2];
#pragma unroll
        for (int bj = 0; bj < 2; ++bj)
#pragma unroll
            for (int n = 0; n < 2; ++n) { bv[bj][n] = *(const f32x4*)(bias + ocol + bj * 32 + 4 * n); gv[bj][n] = *(const f32x4*)(gsrc + bj * 32 + 8 * fq + 4 * n) * (isk ? 1.f : 0.18033688011112042f); }
        const bool x2 = fq >= 2; const int fi = 8 * (fq & 1);
#pragma unroll
        for (int ai = 0; ai < 2; ++ai)
#pragma unroll
            for (int m = 0; m < 4; ++m) { f32x4 v[2][2]; float ss = 0.f;
#pragma unroll
                for (int bj = 0; bj < 2; ++bj)
#pragma unroll
                    for (int n = 0; n < 2; ++n) { v[bj][n] = acc[ai][bj][m][n] + bv[bj][n]; ss += v[bj][n][0] * v[bj][n][0] + v[bj][n][1] * v[bj][n][1] + v[bj][n][2] * v[bj][n][2] + v[bj][n][3] * v[bj][n][3]; }
                ss += xorl<16>(ss); { const auto rr = __builtin_amdgcn_permlane32_swap(__float_as_uint(ss), __float_as_uint(ss), false, false); ss = __uint_as_float(rr[0]) + __uint_as_float(rr[1]); }
                const float rstd = rsqrtf(ss * (1.f / 64.f) + EPS);
                const int l = nb0 + ai * HALF + m * 16;
#pragma unroll
                for (int bj = 0; bj < 2; ++bj) { const int pos = bj == 0 ? (l >> 6) : (l & 63);
                    u32x4 w;
#pragma unroll
                    for (int n = 0; n < 2; ++n) { f32x4 x = v[bj][n] * rstd * gv[bj][n];
                        if (lat) { const f32x4 c01 = *(const f32x4*)(rope + (pos * 16 + fi + 4 * n) * 2), c23 = *(const f32x4*)(rope + (pos * 16 + fi + 4 * n + 2) * 2);
                            const float cs[4] = {c01[0], c01[2], c23[0], c23[2]}, sn[4] = {c01[1], c01[3], c23[1], c23[3]};
#pragma unroll
                            for (int k = 0; k < 4; ++k) { const float other = xor32(x[k], x2); x[k] = x2 ? (other * sn[k] + x[k] * cs[k]) : (x[k] * cs[k] - other * sn[k]); } }
                        if (n == 0) { w.x = cvt_pk_bf16(x[0], x[1]); w.y = cvt_pk_bf16(x[2], x[3]); } else { w.z = cvt_pk_bf16(x[0], x[1]); w.w = cvt_pk_bf16(x[2], x[3]); } }
                    *(u32x4*)(dst + (size_t)(row0 + ai * HALF + m * 16) * 1024 + grp * 64 + bj * 32 + 8 * fq) = w; } }
    }
    __device__ __forceinline__ void ml_tile(const f32x4 (&acc)[2][2][4][2], const Unit& u, int wr, int wc, int fr, int fq) const {
        const int row0 = u.pm * BM + wr * 64 + fr, col0 = u.pn * BM + wc * 32 + 8 * fq; const float ksc = u.pn >= C_MLK / BM ? 0.0625f : 1.f;
        const bool halo = fr < 2 || fr > 13, inner = fr >= 1 && fr <= 14;
#pragma unroll
        for (int bj = 0; bj < 2; ++bj) { const int c = col0 + bj * HALF;
            f32x4 bb[2], w0[2], w1[2], w2[2], cbv[2];
#pragma unroll
            for (int n = 0; n < 2; ++n) { bb[n] = *(const f32x4*)(bias + c + 4 * n); w0[n] = *(const f32x4*)(cw + c + 4 * n); w1[n] = *(const f32x4*)(cw + 2048 + c + 4 * n); w2[n] = *(const f32x4*)(cw + 4096 + c + 4 * n); cbv[n] = *(const f32x4*)(cb + c + 4 * n); }
#pragma unroll
            for (int ai = 0; ai < 2; ++ai)
#pragma unroll
                for (int m = 0; m < 4; ++m) { const size_t row = (size_t)(row0 + ai * HALF + m * 16); u32x4 wr_, wo;
#pragma unroll
                    for (int n = 0; n < 2; ++n) { const f32x4 x = acc[ai][bj][m][n] + bb[n]; f32x4 o;
#pragma unroll
                        for (int k = 0; k < 4; ++k) { const float xp = dppf<0x111>(x[k], x[k]), xn = dppf<0x101>(x[k], x[k]);
                            o[k] = siluf_(cbv[n][k] + w0[n][k] * xp + w1[n][k] * x[k] + w2[n][k] * xn) * ksc; }
                        if (n == 0) { wr_.x = cvt_pk_bf16(x[0], x[1]); wr_.y = cvt_pk_bf16(x[2], x[3]); wo.x = cvt_pk_bf16(o[0], o[1]); wo.y = cvt_pk_bf16(o[2], o[3]); }
                        else { wr_.z = cvt_pk_bf16(x[0], x[1]); wr_.w = cvt_pk_bf16(x[2], x[3]); wo.z = cvt_pk_bf16(o[0], o[1]); wo.w = cvt_pk_bf16(o[2], o[3]); } }
                    if (halo) *(u32x4*)(O + row * NPROJ + c) = wr_;
                    if (inner) *(u32x4*)(QKo + row * 2048 + c) = wo; } }
    }
    __device__ __forceinline__ void operator()(const f32x4 (&acc)[2][2][4][2], const Unit& u, int wr, int wc, int fr, int fq) const {
        if (u.pn >= C_DAQ / BM && u.pn < C_DAV / BM) { qk_tile(acc, u, wr, wc, fr, fq); return; }
        if (u.pn < C_MLV / BM) { ml_tile(acc, u, wr, wc, fr, fq); return; }
        const int row0 = u.pm * BM + wr * 64 + fr;
        const int col0 = u.pn * BM + wc * 32 + 8 * fq, bcol0 = col0 < 4096 ? col0 : col0 + 16;
        const bool s5t = (u.pn >= C_S5U / BM) && (u.pn < C_DAQ / BM); const int s5b = (u.pm * BM) / NTOK, s5row = s5b * 144 + ((u.pm * BM - s5b * NTOK + wr * 64) >> 4);
        f32x4 bv[2][2];
#pragma unroll
        for (int bj = 0; bj < 2; ++bj)
#pragma unroll
            for (int n = 0; n < 2; ++n) bv[bj][n] = *(const f32x4*)(bias + bcol0 + bj * HALF + 4 * n);
#pragma unroll
        for (int ai = 0; ai < 2; ++ai)
#pragma unroll
            for (int m = 0; m < 4; ++m) { bf16_t* rowp = O + (size_t)(row0 + ai * HALF + m * 16) * NPROJ + col0;
#pragma unroll
                for (int bj = 0; bj < 2; ++bj) { const f32x4 v0 = acc[ai][bj][m][0] + bv[bj][0], v1 = acc[ai][bj][m][1] + bv[bj][1];
                    u32x4 w; w.x = cvt_pk_bf16(v0[0], v0[1]); w.y = cvt_pk_bf16(v0[2], v0[3]); w.z = cvt_pk_bf16(v1[0], v1[1]); w.w = cvt_pk_bf16(v1[2], v1[3]);
                    if (s5t) { const int ch = col0 + bj * HALF - C_S5U;
                        *(u32x4*)(A2 + ((size_t)(ch >> 4) * S5ROWS + s5row + ai * 8 + m) * 512 + 256 + (fr & 15) * 16 + (ch & 15)) = w; }
                    else *(u32x4*)(rowp + bj * HALF) = w; } }
    }
};
struct EpiGlu {
    static constexpr bool PERM = true, AFTER_DRAIN = false, KEEP = false;
    const bf16_t* Z5; bf16_t* O; const float* bias;
    __device__ __forceinline__ void operator()(const f32x4 (&acc)[2][2][4][2], const Unit& u, int wr, int wc, int fr, int fq) const {
        const int row0 = u.pm * BM + wr * 64 + fr, col0 = u.pn * BM + wc * 32 + 8 * fq;
#pragma unroll
        for (int ai = 0; ai < 2; ++ai)
#pragma unroll
            for (int m = 0; m < 4; ++m) { const size_t off = (size_t)(row0 + ai * HALF + m * 16) * MIXW + col0;
#pragma unroll
                for (int bj = 0; bj < 2; ++bj) { const u32x4 zz = *(const u32x4*)(Z5 + off + bj * HALF);
                    const f32x4 b0 = *(const f32x4*)(bias + col0 + bj * HALF), b1 = *(const f32x4*)(bias + col0 + bj * HALF + 4);
                    const f32x4 v0 = acc[ai][bj][m][0] + b0, v1 = acc[ai][bj][m][1] + b1;
                    u32x4 w;
                    w.x = cvt_pk_bf16(bflo(zz.x) * sigmoidf_(v0[0]), bfhi(zz.x) * sigmoidf_(v0[1])); w.y = cvt_pk_bf16(bflo(zz.y) * sigmoidf_(v0[2]), bfhi(zz.y) * sigmoidf_(v0[3]));
                    w.z = cvt_pk_bf16(bflo(zz.z) * sigmoidf_(v1[0]), bfhi(zz.z) * sigmoidf_(v1[1])); w.w = cvt_pk_bf16(bflo(zz.w) * sigmoidf_(v1[2]), bfhi(zz.w) * sigmoidf_(v1[3]));
                    *(u32x4*)(O + off + bj * HALF) = w; } }
    }
};
struct EpiBranch {
    static constexpr bool PERM = true, AFTER_DRAIN = false, KEEP = true;
    const bf16_t* GB; bf16_t* MGB;
    __device__ __forceinline__ float em(float x) const { return __expf(-fminf(fmaxf(x, -30.f), 30.f)); }
    __device__ __forceinline__ void operator()(f32x4 (&acc)[2][2][4][2], const Unit& u, int wr, int wc, int fr, int fq) const {
        const int row0 = u.pm * BM + wr * 64 + fr, col0 = u.pn * BM + wc * 32 + 8 * fq; const int r = u.pr;
#pragma unroll
        for (int ai = 0; ai < 2; ++ai)
#pragma unroll
            for (int m = 0; m < 4; ++m) { const size_t row = (size_t)(row0 + ai * HALF + m * 16);
#pragma unroll
                for (int bj = 0; bj < 2; ++bj) { const int c = col0 + bj * HALF; const u32x4 ga = *(const u32x4*)(GB + row * NPROJ + r * DM + c);
                    float sc[8];
                    if (r < 2) { const u32x4 gn = *(const u32x4*)(GB + row * NPROJ + (r + 1) * DM + c);
#pragma unroll
                        for (int k = 0; k < 4; ++k) { sc[2 * k] = (1.f + em(bflo(gn[k]))) * __builtin_amdgcn_rcpf(1.f + em(bflo(ga[k]))); sc[2 * k + 1] = (1.f + em(bfhi(gn[k]))) * __builtin_amdgcn_rcpf(1.f + em(bfhi(ga[k]))); }
                    } else {
#pragma unroll
                        for (int k = 0; k < 4; ++k) { sc[2 * k] = __builtin_amdgcn_rcpf(1.f + em(bflo(ga[k]))); sc[2 * k + 1] = __builtin_amdgcn_rcpf(1.f + em(bfhi(ga[k]))); } }
                    f32x4 v0 = acc[ai][bj][m][0], v1 = acc[ai][bj][m][1];
                    v0[0] *= sc[0]; v0[1] *= sc[1]; v0[2] *= sc[2]; v0[3] *= sc[3]; v1[0] *= sc[4]; v1[1] *= sc[5]; v1[2] *= sc[6]; v1[3] *= sc[7];
                    acc[ai][bj][m][0] = v0; acc[ai][bj][m][1] = v1;
                    if (r == 2) { u32x4 w; w.x = cvt_pk_bf16(v0[0], v0[1]); w.y = cvt_pk_bf16(v0[2], v0[3]); w.z = cvt_pk_bf16(v1[0], v1[1]); w.w = cvt_pk_bf16(v1[2], v1[3]); *(u32x4*)(MGB + row * DM + c) = w; } } }
    }
};
struct BranchOrder {
    StaticOrder T;
    __device__ __forceinline__ bool next(int i, Unit& u) const { if (!T.next(i / 3, u)) return false; const int r = i % 3; u.pr = r; u.pa = r * (MROWS / BM) + u.pm; u.pb = r * (DM / BM) + u.pn; return true; }
    __device__ __forceinline__ void a_ready(const Unit&) const {}
    __device__ __forceinline__ void done(const Unit&) const {}
};
struct EpiOut {
    static constexpr bool PERM = true, AFTER_DRAIN = false, KEEP = false;
    bf16_t* Z; const float* MODL;
    __device__ __forceinline__ void operator()(const f32x4 (&acc)[2][2][4][2], const Unit& u, int wr, int wc, int fr, int fq) const {
        const int row0 = u.pm * BM + wr * 64 + fr, col0 = u.pn * BM + wc * 32 + 8 * fq;
        const int rs = row_sel(u.pm * BM);
        const float* g2 = MODL + (size_t)rs * (6 * DM) + 2 * DM;
#pragma unroll
        for (int ai = 0; ai < 2; ++ai)
#pragma unroll
            for (int m = 0; m < 4; ++m) { bf16_t* zr = Z + (size_t)(row0 + ai * HALF + m * 16) * DM;
#pragma unroll
                for (int bj = 0; bj < 2; ++bj) { const int c = col0 + bj * HALF;
                    const f32x4 ga = *(const f32x4*)(g2 + c), gb = *(const f32x4*)(g2 + c + 4); const u32x4 zo = *(const u32x4*)(zr + c);
                    const f32x4 v0 = (f32x4){bflo(zo.x), bfhi(zo.x), bflo(zo.y), bfhi(zo.y)} + ga * acc[ai][bj][m][0], v1 = (f32x4){bflo(zo.z), bfhi(zo.z), bflo(zo.w), bfhi(zo.w)} + gb * acc[ai][bj][m][1];
                    u32x4 w; w.x = cvt_pk_bf16(v0[0], v0[1]); w.y = cvt_pk_bf16(v0[2], v0[3]); w.z = cvt_pk_bf16(v1[0], v1[1]); w.w = cvt_pk_bf16(v1[2], v1[3]); *(u32x4*)(zr + c) = w; } }
    }
};
struct EpiGateUp {
    static constexpr bool PERM = true, AFTER_DRAIN = false, KEEP = false;
    bf16_t* ACT;
    __device__ __forceinline__ void operator()(const f32x4 (&acc)[2][2][4][2], const Unit& u, int wr, int wc, int fr, int fq) const {
        const int row0 = u.pm * BM + wr * 64 + fr, f0 = u.pn * HALF + wc * 32 + 8 * fq;
#pragma unroll
        for (int ai = 0; ai < 2; ++ai)
#pragma unroll
            for (int m = 0; m < 4; ++m) { const f32x4 g0 = acc[ai][0][m][0], g1 = acc[ai][0][m][1], u0 = acc[ai][1][m][0], u1 = acc[ai][1][m][1];
                u32x4 w; w.x = cvt_pk_bf16(siluf_(g0[0]) * u0[0], siluf_(g0[1]) * u0[1]); w.y = cvt_pk_bf16(siluf_(g0[2]) * u0[2], siluf_(g0[3]) * u0[3]);
                w.z = cvt_pk_bf16(siluf_(g1[0]) * u1[0], siluf_(g1[1]) * u1[1]); w.w = cvt_pk_bf16(siluf_(g1[2]) * u1[2], siluf_(g1[3]) * u1[3]);
                *(u32x4*)(ACT + (size_t)(row0 + ai * HALF + m * 16) * DFF + f0) = w; }
    }
};
struct EpiPlainBf16 {
    static constexpr bool PERM = true, AFTER_DRAIN = false, KEEP = false;
    bf16_t* O; int ldc;
    __device__ __forceinline__ void operator()(const f32x4 (&acc)[2][2][4][2], const Unit& u, int wr, int wc, int fr, int fq) const {
        const int row0 = u.pm * BM + wr * 64 + fr, col0 = u.pn * BM + wc * 32 + 8 * fq;
#pragma unroll
        for (int ai = 0; ai < 2; ++ai)
#pragma unroll
            for (int m = 0; m < 4; ++m) { bf16_t* rowp = O + (size_t)(row0 + ai * HALF + m * 16) * ldc + col0;
#pragma unroll
                for (int bj = 0; bj < 2; ++bj) { const f32x4 v0 = acc[ai][bj][m][0], v1 = acc[ai][bj][m][1];
                    u32x4 w; w.x = cvt_pk_bf16(v0[0], v0[1]); w.y = cvt_pk_bf16(v0[2], v0[3]); w.z = cvt_pk_bf16(v1[0], v1[1]); w.w = cvt_pk_bf16(v1[2], v1[3]);
                    *(u32x4*)(rowp + bj * HALF) = w; } }
    }
};
struct MoeOrder {
    const int* pre;
    int ncol, G, c;
    __device__ __forceinline__ bool next(int i, Unit& u) const {
        const int L = i * G + c; const int tot = pre[16];
        if (L >= tot * ncol) return false;
        const int tg = L / ncol, pn = L % ncol; int e = 0;
#pragma unroll
        for (int k = 1; k < 16; ++k) e += (tg >= pre[k]) ? 1 : 0;
        u.pm = e * (ECAP / BM) + (tg - pre[e]); u.pn = pn; u.pb = e * ncol + pn; u.pa = u.pm; u.pr = 0; return true;
    }
    __device__ __forceinline__ void a_ready(const Unit&) const {}
    __device__ __forceinline__ void done(const Unit&) const {}
};
}

__device__ __forceinline__ int tok_of(int pp, int dir) { return dir == 0 ? pp : (pp < CTX ? CTX - 1 - pp : NTOK + CTX - 1 - pp); }
__device__ __forceinline__ void phase_mlconv(const P& p, int L, int bid, int nblk) { unsigned char* const ws = lp_(p.ws);
    const int tid = tid_(), wave = tid >> 6, lane = tid & 63;
    const bf16* PROJ = (const bf16*)(ws + WS_RA + RA_PROJ); bf16* QK = (bf16*)(ws + WS_RA + RA_QK);
    const float* cw = p.in[I_MLCW] + (size_t)L * 3 * 2048; const float* cb = p.in[I_MLCB] + L * 2048;
    for (int i = bid * 8 + wave; i < MROWS / 8; i += nblk * 8) {
        const int m = (i >> 1) * 16 + ((i & 1) ? 15 : 0);
        const int n = m % NTOK; const bool hp = !(n == 0 || n == CTX), hn = !(n == CTX - 1 || n == NTOK - 1);
#pragma unroll
        for (int j = 0; j < 4; ++j) { const int c = 8 * lane + 512 * j;
            const u32x4 xc = *(const u32x4*)(PROJ + (size_t)m * NPROJ + c);
            u32x4 xp = {0u, 0u, 0u, 0u}, xn = {0u, 0u, 0u, 0u};
            if (hp) xp = *(const u32x4*)(PROJ + (size_t)(m - 1) * NPROJ + c);
            if (hn) xn = *(const u32x4*)(PROJ + (size_t)(m + 1) * NPROJ + c);
            float o[8];
#pragma unroll
            for (int k = 0; k < 8; ++k) { const unsigned wp = xp[k >> 1], wc = xc[k >> 1], wn = xn[k >> 1];
                const float vp = (k & 1) ? bfhi(wp) : bflo(wp), vc = (k & 1) ? bfhi(wc) : bflo(wc), vn = (k & 1) ? bfhi(wn) : bflo(wn);
                const float y = cb[c + k] + cw[c + k] * vp + cw[2048 + c + k] * vc + cw[4096 + c + k] * vn;
                o[k] = siluf_(y) * (c >= 1024 ? 0.0625f : 1.f); }
            u32x4 w; w.x = pk2(o[0], o[1]); w.y = pk2(o[2], o[3]); w.z = pk2(o[4], o[5]); w.w = pk2(o[6], o[7]);
            *(u32x4*)(QK + (size_t)m * 2048 + c) = w; }
    }
}
__device__ __forceinline__ void phase_qkprep(const P& p, int L, int bid, int nblk) { unsigned char* const ws = lp_(p.ws);
    const int tid = tid_(), wave = tid >> 6, lane = tid & 63;
    const bf16* PROJ = (const bf16*)(ws + WS_RA + RA_PROJ);
    const float* rope = (const float*)(ws + WS_ROPE);
    const int grp = lane >> 2, l4 = lane & 3;
    for (int m = bid * 8 + wave; m < MROWS; m += nblk * 8) {
        const int n = m % NTOK; const bool lat = n >= CTX; const int l = n - CTX; const int pos = (l4 < 2) ? (l >> 6) : (l & 63);
#pragma unroll
        for (int qk = 0; qk < 2; ++qk) {
            const bf16* src = PROJ + (size_t)m * NPROJ + (qk ? C_DAK : C_DAQ) + grp * 64 + l4 * 16;
            const float* g = p.in[qk ? I_DAKG : I_DAQG] + L * 64 + l4 * 16;
            bf16* dst = (bf16*)(ws + WS_RA + (qk ? RA_KN : RA_QN)) + (size_t)m * 1024 + grp * 64 + l4 * 16;
            const u32x4 a = *(const u32x4*)src, b = *(const u32x4*)(src + 8);
            float v[16];
#pragma unroll
            for (int k = 0; k < 4; ++k) { v[2 * k] = bflo(a[k]); v[2 * k + 1] = bfhi(a[k]); v[8 + 2 * k] = bflo(b[k]); v[8 + 2 * k + 1] = bfhi(b[k]); }
            float ss = 0.f;
#pragma unroll
            for (int k = 0; k < 16; ++k) ss += v[k] * v[k];
            ss += xorl<1>(ss); ss += xorl<2>(ss);
            const float rstd = rsqrtf(ss * (1.f / 64.f) + EPS);
#pragma unroll
            for (int k = 0; k < 16; ++k) v[k] = v[k] * rstd * g[k];
            float o[16];
#pragma unroll
            for (int k = 0; k < 16; ++k) { const float other = xorl<1>(v[k]);
                float r = v[k];
                if (lat) { const float cs = rope[(pos * 16 + k) * 2], sn = rope[(pos * 16 + k) * 2 + 1];
                    r = (l4 & 1) ? (other * sn + v[k] * cs) : (v[k] * cs - other * sn); }
                o[k] = r; }
            u32x4 w0, w1; w0.x = pk2(o[0], o[1]); w0.y = pk2(o[2], o[3]); w0.z = pk2(o[4], o[5]); w0.w = pk2(o[6], o[7]);
            w1.x = pk2(o[8], o[9]); w1.y = pk2(o[10], o[11]); w1.z = pk2(o[12], o[13]); w1.w = pk2(o[14], o[15]);
            *(u32x4*)dst = w0; *(u32x4*)(dst + 8) = w1;
        }
    }
}

namespace pg8 {
struct S5Order {
    int G, c;
    __device__ __forceinline__ bool next(int i, Unit& u) const { const int L = i * G + c; if (L >= 192) return false; u.pm = L; u.pn = 0; u.pb = L / 3; u.pa = L; u.pr = 0; return true; }
    __device__ __forceinline__ void a_ready(const Unit&) const {}
    __device__ __forceinline__ void done(const Unit&) const {}
};
struct EpiS5E {
    static constexpr bool PERM = true, AFTER_DRAIN = false, KEEP = false;
    float* E;
    __device__ __forceinline__ void operator()(const f32x4 (&acc)[2][2][4][2], const Unit& u, int wr, int wc, int fr, int fq) const {
        const int row0 = u.pm * BM + wr * 64 + fr, col0 = wc * 32 + 8 * fq;
#pragma unroll
        for (int ai = 0; ai < 2; ++ai)
#pragma unroll
            for (int m = 0; m < 4; ++m) { float* rp = E + (size_t)(row0 + ai * HALF + m * 16) * 256 + col0;
#pragma unroll
                for (int bj = 0; bj < 2; ++bj) { *(f32x4*)(rp + bj * HALF) = acc[ai][bj][m][0]; *(f32x4*)(rp + bj * HALF + 4) = acc[ai][bj][m][1]; } }
    }
};
struct EpiS5Y {
    static constexpr bool PERM = true, AFTER_DRAIN = false, KEEP = false;
    bf16_t* Z5;
    __device__ __forceinline__ void operator()(const f32x4 (&acc)[2][2][4][2], const Unit& u, int wr, int wc, int fr, int fq) const {
        const int g = u.pm / 3, rbase = (u.pm % 3) * BM + wr * 64 + fr, col0 = wc * 32 + 8 * fq;
#pragma unroll
        for (int ai = 0; ai < 2; ++ai)
#pragma unroll
            for (int m = 0; m < 4; ++m) { const int rr = rbase + ai * HALF + m * 16;
                if (rr < 576) { const int b = rr / 144, kb = rr % 144;
#pragma unroll
                    for (int bj = 0; bj < 2; ++bj) { const int c = col0 + bj * HALF, tau = c >> 4, i0 = c & 15; const f32x4 v0 = acc[ai][bj][m][0], v1 = acc[ai][bj][m][1];
                        u32x4 w; w.x = cvt_pk_bf16(gelu_tanh(v0[0]), gelu_tanh(v0[1])); w.y = cvt_pk_bf16(gelu_tanh(v0[2]), gelu_tanh(v0[3]));
                        w.z = cvt_pk_bf16(gelu_tanh(v1[0]), gelu_tanh(v1[1])); w.w = cvt_pk_bf16(gelu_tanh(v1[2]), gelu_tanh(v1[3]));
                        *(u32x4*)(Z5 + ((size_t)b * NTOK + 16 * kb + tau) * MIXW + g * 16 + i0) = w; } } }
    }
};
}
__device__ __forceinline__ void phase_s5_gemm1(const P& p, int L, LAS unsigned char* lds, int bid, int nblk) { unsigned char* const ws = lp_(p.ws);
    pg8::Gemm g{(const bf16*)(ws + WS_RA + RA_S5A) + 256, (const bf16*)(ws + WS_S5T1 + L * SZ_S5T1), 64 * S5ROWS, 256, 256, 512}; pg8::S5Order S{nblk, bid};
    pg8::EpiS5E E{(float*)(ws + WS_RA + RA_S5E)};
    pg8::gemm_phase<pg8::EpiS5E, pg8::S5Order, true, true>(lds, g, S, E); }
__device__ __forceinline__ void phase_s5_gemm2(const P& p, int L, LAS unsigned char* lds, int bid, int nblk) { unsigned char* const ws = lp_(p.ws);
    pg8::Gemm g{(const bf16*)(ws + WS_RA + RA_S5A), (const bf16*)(ws + WS_S5T2 + L * SZ_S5T2), 64 * S5ROWS, 256, 512, 512}; pg8::S5Order S{nblk, bid};
    pg8::EpiS5Y E{(bf16*)(ws + WS_RA + RA_Z5)};
    pg8::gemm_phase<pg8::EpiS5Y, pg8::S5Order, true, true>(lds, g, S, E); }
__device__ __forceinline__ void phase_s5_scan(const P& p, int L, int bid, int nblk) { unsigned char* const ws = lp_(p.ws);
    const int tid = tid_(), wave = tid >> 6, lane = tid & 63;
    const float* S5 = (const float*)(ws + WS_S5P + L * S5P_STRIDE);
    const float* E = (const float*)(ws + WS_RA + RA_S5E); bf16* A2 = (bf16*)(ws + WS_RA + RA_S5A);
    for (int seq = bid * 8 + wave; seq < 512; seq += nblk * 8) {
        const int dir = seq & 1, b = (seq >> 1) & 3, g = seq >> 3; const int q = dir * 4096 + g * 64 + lane;
        const float are = S5[16384 + q * 2], aim = S5[16384 + q * 2 + 1];
        float s_re = 0.f, s_im = 0.f;
        const size_t rbase = (size_t)g * S5ROWS + b * 144;
        const float* Eb = E + rbase * 256 + dir * 128 + lane; bf16* Ab = A2 + rbase * 512 + dir * 128 + lane;
#define S5_KB(k) (dir == 0 ? (k) : ((k) < 16 ? 15 - (k) : 159 - (k)))
        float cr[16], ci[16], nr_[16], ni_[16];
#pragma unroll
        for (int t = 0; t < 16; ++t) { const int kb = S5_KB(t); cr[t] = Eb[(size_t)kb * 256]; ci[t] = Eb[(size_t)kb * 256 + 64]; }
#pragma unroll 1
        for (int g = 0; g < 9; ++g) {
            const int gn = g + 1 < 9 ? g + 1 : g;
#pragma unroll
            for (int t = 0; t < 16; ++t) { const int kb = S5_KB(gn * 16 + t); nr_[t] = Eb[(size_t)kb * 256]; ni_[t] = Eb[(size_t)kb * 256 + 64]; }
#pragma unroll
            for (int t = 0; t < 16; ++t) { const int kb = S5_KB(g * 16 + t);
                Ab[(size_t)kb * 512] = (bf16)f2bf(s_re); Ab[(size_t)kb * 512 + 64] = (bf16)f2bf(s_im);
                const float nr = are * s_re - aim * s_im + cr[t], ni = are * s_im + aim * s_re + ci[t]; s_re = nr; s_im = ni; }
#pragma unroll
            for (int t = 0; t < 16; ++t) { cr[t] = nr_[t]; ci[t] = ni_[t]; } }
#undef S5_KB
    }
}
__device__ __forceinline__ void prologue_s5tables(const P& p, unsigned char* lds, int bid, int nblk) { unsigned char* const ws = lp_(p.ws);
    const int tid = tid_();
    float* ap = (float*)lds;
    float* bb = ap + 2 * 17 * 64 * 2;
    float* cc = bb + 2 * 64 * 16 * 2;
    float* KK = cc + 16 * 64 * 2;
    for (int u = bid; u < DEPTH * 64; u += nblk) {
        const int L = u >> 6, g = u & 63;
        __syncthreads();
        for (int i = tid; i < 2 * 17 * 64; i += NT) { const int dir = i / (17 * 64), dl = (i / 64) % 17, pp = i % 64; const int li = ((L * 2 + dir) * 64 + g) * 64 + pp;
            const float dt = expf(p.in[I_S5DT][(L * 2 + dir) * 64 + g]); const float x = p.in[I_S5LR][li] * dt * (float)dl, th = p.in[I_S5LI][li] * dt * (float)dl; const float mg = expf(x);
            ap[i * 2] = mg * cosf(th); ap[i * 2 + 1] = mg * sinf(th); }
        { const float* BB = (const float*)(ws + WS_S5P + L * S5P_STRIDE) + 32768;
          for (int i = tid; i < 2 * 64 * 32; i += NT) { const int dir = i / 2048, r = i % 2048; bb[i] = BB[(size_t)(dir * 4096 + g * 64) * 32 + r]; } }
        for (int i = tid; i < 16 * 64; i += NT) { cc[i * 2] = p.in[I_S5CR][((size_t)L * 64 + g) * 1024 + i]; cc[i * 2 + 1] = p.in[I_S5CI][((size_t)L * 64 + g) * 1024 + i]; }
        __syncthreads();
        if (nblk * 0 == 0) {
            const int dir = tid >> 8, dl = (tid >> 4) & 15, ib = ((tid >> 2) & 3) * 4, jb = (tid & 3) * 4;
            float acc[4][4];
#pragma unroll
            for (int a = 0; a < 4; ++a)
#pragma unroll
                for (int c = 0; c < 4; ++c) acc[a][c] = 0.f;
            for (int pp = 0; pp < 64; ++pp) { const float2 av = *(const float2*)(ap + ((dir * 17 + dl) * 64 + pp) * 2);
                const f32x4 b01 = *(const f32x4*)(bb + ((dir * 64 + pp) * 16 + jb) * 2), b23 = *(const f32x4*)(bb + ((dir * 64 + pp) * 16 + jb + 2) * 2);
                const float zr[4] = {av.x * b01.x - av.y * b01.y, av.x * b01.z - av.y * b01.w, av.x * b23.x - av.y * b23.y, av.x * b23.z - av.y * b23.w};
                const float zi[4] = {av.x * b01.y + av.y * b01.x, av.x * b01.w + av.y * b01.z, av.x * b23.y + av.y * b23.x, av.x * b23.w + av.y * b23.z};
#pragma unroll
                for (int a = 0; a < 4; ++a) { const float2 cv = *(const float2*)(cc + ((ib + a) * 64 + pp) * 2);
#pragma unroll
                    for (int c = 0; c < 4; ++c) acc[a][c] += cv.x * zr[c] - cv.y * zi[c]; } }
#pragma unroll
            for (int a = 0; a < 4; ++a)
#pragma unroll
                for (int c = 0; c < 4; ++c) KK[((dir * 16 + dl) * 16 + ib + a) * 16 + jb + c] = acc[a][c];
        }
        __syncthreads();
        bf16* T1 = (bf16*)(ws + WS_S5T1 + L * SZ_S5T1) + (size_t)g * 256 * 256; bf16* T2 = (bf16*)(ws + WS_S5T2 + L * SZ_S5T2) + (size_t)g * 256 * 512;
        for (int ch = tid; ch < 256 * 32; ch += NT) { const int n = ch >> 5, k0 = (ch & 31) * 8; const int dir = n >> 7, part = (n >> 6) & 1, pp = n & 63; const int tau = k0 >> 4, i0 = k0 & 15;
            const int ex = dir == 0 ? 15 - tau : tau; const float ar = ap[((dir * 17 + ex) * 64 + pp) * 2], ai = ap[((dir * 17 + ex) * 64 + pp) * 2 + 1];
            float v[8];
#pragma unroll
            for (int j = 0; j < 8; ++j) { const float br = bb[((dir * 64 + pp) * 16 + i0 + j) * 2], bi = bb[((dir * 64 + pp) * 16 + i0 + j) * 2 + 1]; v[j] = part == 0 ? ar * br - ai * bi : ar * bi + ai * br; }
            u32x4 w; w.x = pk2(v[0], v[1]); w.y = pk2(v[2], v[3]); w.z = pk2(v[4], v[5]); w.w = pk2(v[6], v[7]); *(u32x4*)(T1 + (size_t)n * 256 + k0) = w; }
        const float* dsk = p.in[I_S5D] + L * 1024 + g * 16;
        for (int ch = tid; ch < 256 * 64; ch += NT) { const int n = ch >> 6, k0 = (ch & 63) * 8; const int tau = n >> 4, i = n & 15;
            float v[8];
            if (k0 < 256) { const int dir = k0 >> 7, part = (k0 >> 6) & 1, p0 = k0 & 63; const int ex = dir == 0 ? tau + 1 : 16 - tau;
#pragma unroll
                for (int j = 0; j < 8; ++j) { const int pp = p0 + j; const float ar = ap[((dir * 17 + ex) * 64 + pp) * 2], ai = ap[((dir * 17 + ex) * 64 + pp) * 2 + 1];
                    const float cr = cc[(i * 64 + pp) * 2], ci = cc[(i * 64 + pp) * 2 + 1]; v[j] = part == 0 ? cr * ar - ci * ai : -(cr * ai + ci * ar); }
            } else { const int t2 = (k0 - 256) >> 4, i0 = k0 & 15;
#pragma unroll
                for (int j = 0; j < 8; ++j) { const int i2 = i0 + j; float a = 0.f;
                    if (t2 <= tau) a += KK[((0 * 16 + (tau - t2)) * 16 + i) * 16 + i2];
                    if (t2 >= tau) a += KK[((1 * 16 + (t2 - tau)) * 16 + i) * 16 + i2];
                    if (t2 == tau && i2 == i) a += dsk[i];
                    v[j] = a; } }
            u32x4 w; w.x = pk2(v[0], v[1]); w.y = pk2(v[2], v[3]); w.z = pk2(v[4], v[5]); w.w = pk2(v[6], v[7]); *(u32x4*)(T2 + (size_t)n * 512 + k0) = w; }
    }
}

namespace ml {
using bf16x8 = __attribute__((ext_vector_type(8))) short;
using s16x4  = __attribute__((ext_vector_type(4))) short;
typedef short v4i16_t __attribute__((ext_vector_type(4)));
constexpr int NET = 5;
constexpr int RS = 528, VRS = NET * 32, SRS = 144;
constexpr int OFF_Q = 0, OFF_K = 64 * RS, OFF_C = 2 * 64 * RS, OFF_V = OFF_C + NET * 16 * RS, OFF_VW = OFF_V + 64 * VRS, OFF_SM = OFF_VW + 64 * VRS, OFF_DEN = OFF_SM + 64 * SRS, LDS_END = OFF_DEN + 256;
static_assert(LDS_END <= 140 * 1024, "mLSTM LDS map");
__device__ __forceinline__ bf16x8 ldfrag(const LAS unsigned char* p) { return *(const LAS bf16x8*)p; }
__device__ __forceinline__ s16x4 trfrag(const LAS unsigned char* p) { return __builtin_bit_cast(s16x4, __builtin_amdgcn_ds_read_tr16_b64_v4i16((LAS v4i16_t*)p)); }
__device__ __forceinline__ bf16x8 cat4(s16x4 l, s16x4 h) { return (bf16x8){l[0], l[1], l[2], l[3], h[0], h[1], h[2], h[3]}; }
}
__device__ __forceinline__ void phase_mlstm(const P& p, int L, LAS unsigned char* lds, int bid, int nblk) { unsigned char* const ws = lp_(p.ws);
    using namespace ml;
    const int tid = tid_(), wave = __builtin_amdgcn_readfirstlane(tid >> 6), lane = tid & 63, l15 = lane & 15, quad = lane >> 4;
    const bf16* PROJ = (const bf16*)(ws + WS_RA + RA_PROJ); const bf16* QK = (const bf16*)(ws + WS_RA + RA_QK);
    const float* GATES = (const float*)(ws + WS_GATES); float* HML = (float*)(ws + WS_RA + RA_HML);
    const int tt = wave & 3, sh = wave >> 2;
    for (int task = bid; task < 128; task += nblk) {
        const int b = task >> 5, h = (task >> 3) & 3, dir = (task >> 2) & 1, es = task & 3;
        { unsigned z0 = 0u; asm volatile("" : "+v"(z0)); for (int i = tid; i < NET * 16 * RS / 16; i += NT) *(LAS u32x4*)(lds + OFF_C + i * 16) = (u32x4){z0, z0, z0, z0}; }
        f32x4 Cacc[2][NET];
#pragma unroll
        for (int a = 0; a < 2; ++a)
#pragma unroll
            for (int e = 0; e < NET; ++e) Cacc[a][e] = (f32x4){0.f, 0.f, 0.f, 0.f};
        float m_prev = 0.f;
        u32x4 rq[4], rk[4], rv; float rig, rfg;
#define ML_LOAD(c) do { _Pragma("unroll") for (int i = 0; i < 4; ++i) { const int id = tid + NT * i, j = id >> 5, ch = id & 31; const size_t m = (size_t)b * NTOK + tok_of(64 * (c) + j, dir); \
            rq[i] = *(const u32x4*)(QK + m * 2048 + h * 256 + ch * 8); rk[i] = *(const u32x4*)(QK + m * 2048 + 1024 + h * 256 + ch * 8); } \
        { const int j = tid >> 3, ch = tid & 7; const size_t m = (size_t)b * NTOK + tok_of(64 * (c) + j, dir); rv = *(const u32x4*)(PROJ + m * NPROJ + C_MLV + h * 256 + es * 64 + ch * 8); } \
        { const size_t m = (size_t)b * NTOK + tok_of(64 * (c) + lane, dir); rig = GATES[m * 16 + (2 * dir) * 4 + h]; rfg = GATES[m * 16 + (2 * dir + 1) * 4 + h]; } } while (0)
        ML_LOAD(0);
        __syncthreads();
        for (int c = 0; c < 36; ++c) {
            float bc = log_sigmoid(rfg);
            bc = wave_scan<false>(bc);
            const float ga = rig - bc; float cm = ga;
            cm = wave_scan<true>(cm);
            const float gM = fmaxf(m_prev, cm); const float M63 = rdlane(gM, 63), b63 = rdlane(bc, 63);
            const float gwin = __expf(m_prev - gM), gnrm = __expf(-(bc + gM)), gwS = __expf(ga - M63), decay = __expf(m_prev - M63);
            m_prev = b63 + M63;
#pragma unroll
            for (int i = 0; i < 4; ++i) { const int id = tid + NT * i, j = id >> 5, ch = id & 31; *(LAS u32x4*)(lds + OFF_Q + j * RS + ch * 16) = rq[i]; *(LAS u32x4*)(lds + OFF_K + j * RS + ch * 16) = rk[i]; }
            { const int j = tid >> 3, ch = tid & 7; const float wj = bperm(gwS, j);
                *(LAS u32x4*)(lds + OFF_V + j * VRS + ch * 16) = rv;
                u32x4 w; w.x = pk2(bflo(rv.x) * wj, bfhi(rv.x) * wj); w.y = pk2(bflo(rv.y) * wj, bfhi(rv.y) * wj); w.z = pk2(bflo(rv.z) * wj, bfhi(rv.z) * wj); w.w = pk2(bflo(rv.w) * wj, bfhi(rv.w) * wj);
                *(LAS u32x4*)(lds + OFF_VW + j * VRS + ch * 16) = w;
                if (ch == 0) { unsigned one = 0x3f80u, zz = 0u; asm volatile("" : "+v"(one), "+v"(zz));
                    *(LAS u32x4*)(lds + OFF_V + j * VRS + 128) = (u32x4){one, zz, zz, zz}; *(LAS u32x4*)(lds + OFF_V + j * VRS + 144) = (u32x4){zz, zz, zz, zz};
                    *(LAS u32x4*)(lds + OFF_VW + j * VRS + 128) = (u32x4){f2bf(wj), zz, zz, zz}; *(LAS u32x4*)(lds + OFF_VW + j * VRS + 144) = (u32x4){zz, zz, zz, zz}; } }
            if (c + 1 < 36) ML_LOAD(c + 1);
            __syncthreads();
            f32x4 S0 = {0.f, 0.f, 0.f, 0.f}, S1 = S0, H0 = S0, H1 = S0, H2 = S0;
            {   const LAS unsigned char* qa = lds + OFF_Q + (tt * 16 + l15) * RS + quad * 16;
                const LAS unsigned char* k0 = lds + OFF_K + ((2 * sh) * 16 + l15) * RS + quad * 16; const LAS unsigned char* k1 = k0 + 16 * RS;
                const LAS unsigned char* c0 = lds + OFF_C + ((3 * sh) * 16 + l15) * RS + quad * 16; const LAS unsigned char* c1 = c0 + 16 * RS; const LAS unsigned char* c2 = c0 + 32 * RS;
#pragma unroll
                for (int kk = 0; kk < 8; ++kk) { const bf16x8 a = ldfrag(qa + kk * 64);
                    S0 = __builtin_amdgcn_mfma_f32_16x16x32_bf16(a, ldfrag(k0 + kk * 64), S0, 0, 0, 0);
                    S1 = __builtin_amdgcn_mfma_f32_16x16x32_bf16(a, ldfrag(k1 + kk * 64), S1, 0, 0, 0);
                    H0 = __builtin_amdgcn_mfma_f32_16x16x32_bf16(a, ldfrag(c0 + kk * 64), H0, 0, 0, 0);
                    H1 = __builtin_amdgcn_mfma_f32_16x16x32_bf16(a, ldfrag(c1 + kk * 64), H1, 0, 0, 0);
                    if (sh == 0) H2 = __builtin_amdgcn_mfma_f32_16x16x32_bf16(a, ldfrag(c2 + kk * 64), H2, 0, 0, 0); } }
            float Mt[4], wt[4];
#pragma unroll
            for (int i = 0; i < 4; ++i) { const int t = tt * 16 + quad * 4 + i; Mt[i] = bperm(gM, t); wt[i] = bperm(gwin, t); }
            {   const int s0 = (2 * sh) * 16 + l15, s1 = s0 + 16; const float a0 = bperm(ga, s0), a1 = bperm(ga, s1);
#pragma unroll
                for (int i = 0; i < 4; ++i) { const int t = tt * 16 + quad * 4 + i;
                    const float v0 = s0 <= t ? S0[i] * __expf(a0 - Mt[i]) : 0.f, v1 = s1 <= t ? S1[i] * __expf(a1 - Mt[i]) : 0.f;
                    *(LAS unsigned short*)(lds + OFF_SM + t * SRS + s0 * 2) = (unsigned short)f2bf(v0); *(LAS unsigned short*)(lds + OFF_SM + t * SRS + s1 * 2) = (unsigned short)f2bf(v1);
                    H0[i] *= wt[i]; H1[i] *= wt[i]; H2[i] *= wt[i]; } }
            __syncthreads();
            {   const LAS unsigned char* sa = lds + OFF_SM + (tt * 16 + l15) * SRS + quad * 16;
                const LAS unsigned char* vb = lds + OFF_V + (quad * 8 + (l15 >> 2)) * VRS + (3 * sh) * 32 + (lane & 3) * 8;
#pragma unroll
                for (int k2 = 0; k2 < 2; ++k2) { const bf16x8 a = ldfrag(sa + k2 * 64);
                    H0 = __builtin_amdgcn_mfma_f32_16x16x32_bf16(a, cat4(trfrag(vb + k2 * 32 * VRS), trfrag(vb + k2 * 32 * VRS + 4 * VRS)), H0, 0, 0, 0);
                    H1 = __builtin_amdgcn_mfma_f32_16x16x32_bf16(a, cat4(trfrag(vb + k2 * 32 * VRS + 32), trfrag(vb + k2 * 32 * VRS + 4 * VRS + 32)), H1, 0, 0, 0);
                    if (sh == 0) H2 = __builtin_amdgcn_mfma_f32_16x16x32_bf16(a, cat4(trfrag(vb + k2 * 32 * VRS + 64), trfrag(vb + k2 * 32 * VRS + 4 * VRS + 64)), H2, 0, 0, 0); } }
            if (sh == 1 && l15 == 0) {
#pragma unroll
                for (int i = 0; i < 4; ++i) *(LAS float*)(lds + OFF_DEN + (tt * 16 + quad * 4 + i) * 4) = H1[i]; }
            {   const LAS unsigned char* va = lds + OFF_VW + (quad * 8 + (l15 >> 2)) * VRS + (lane & 3) * 8;
                const LAS unsigned char* kb = lds + OFF_K + (quad * 8 + (l15 >> 2)) * RS + (2 * wave) * 32 + (lane & 3) * 8;
#pragma unroll
                for (int a = 0; a < 2; ++a)
#pragma unroll
                    for (int e = 0; e < NET; ++e) Cacc[a][e] = Cacc[a][e] * decay;
#pragma unroll
                for (int k2 = 0; k2 < 2; ++k2) {
                    bf16x8 bfr[2];
#pragma unroll
                    for (int a = 0; a < 2; ++a) bfr[a] = cat4(trfrag(kb + k2 * 32 * RS + a * 32), trfrag(kb + k2 * 32 * RS + 4 * RS + a * 32));
#pragma unroll
                    for (int e = 0; e < NET; ++e) { const bf16x8 af = cat4(trfrag(va + k2 * 32 * VRS + e * 32), trfrag(va + k2 * 32 * VRS + 4 * VRS + e * 32));
#pragma unroll
                        for (int a = 0; a < 2; ++a) Cacc[a][e] = __builtin_amdgcn_mfma_f32_16x16x32_bf16(bfr[a], af, Cacc[a][e], 0, 0, 0); } }
#pragma unroll
                for (int a = 0; a < 2; ++a)
#pragma unroll
                    for (int e = 0; e < NET; ++e)
                        { u32x2 w; w.x = pk2(Cacc[a][e][0], Cacc[a][e][1]); w.y = pk2(Cacc[a][e][2], Cacc[a][e][3]);
                          *(LAS u32x2*)(lds + OFF_C + (e * 16 + l15) * RS + ((2 * wave + a) * 16 + quad * 4) * 2) = w; } }
            __syncthreads();
            {
#pragma unroll
                for (int i = 0; i < 4; ++i) { const int t = tt * 16 + quad * 4 + i; const float den = *(const LAS float*)(lds + OFF_DEN + t * 4); const float nr = bperm(gnrm, t);
                    const float inv = __builtin_amdgcn_rcpf(fmaxf(fabsf(den), nr)); const size_t m = (size_t)b * NTOK + tok_of(64 * c + t, dir);
                    float* o = HML + ((size_t)dir * MROWS + m) * 1024 + h * 256 + es * 64 + (3 * sh) * 16 + l15; o[0] = H0[i] * inv; if (sh == 0) { o[16] = H1[i] * inv; o[32] = H2[i] * inv; } } }
        }
#undef ML_LOAD
        __syncthreads();
    }
}
__device__ __forceinline__ void phase_mlpost(const P& p, int L, int bid, int nblk) { unsigned char* const ws = lp_(p.ws);
    const int tid = tid_(), wave = tid >> 6, lane = tid & 63;
    const bf16* PROJ = (const bf16*)(ws + WS_RA + RA_PROJ); const float* HML = (const float*)(ws + WS_RA + RA_HML); bf16* YA = (bf16*)(ws + WS_RA + RA_YA);
    const float* ng = p.in[I_MLNG] + L * 1024;
    constexpr int NI = MROWS * 4; const int stride = nblk * 8;
    for (int i0 = bid * 8 + wave; i0 < NI; i0 += 4 * stride) {
        f32x4 va[4], vb[4]; u32x2 oo[4]; int mm[4], cc[4]; bool ok[4];
#pragma unroll
        for (int k = 0; k < 4; ++k) { const int i = i0 + k * stride; ok[k] = i < NI; const int ii = ok[k] ? i : i0; mm[k] = ii >> 2; cc[k] = (ii & 3) * 256 + 4 * lane;
            va[k] = *(const f32x4*)(HML + (size_t)mm[k] * 1024 + cc[k]); vb[k] = *(const f32x4*)(HML + ((size_t)MROWS + mm[k]) * 1024 + cc[k]); oo[k] = *(const u32x2*)(PROJ + (size_t)mm[k] * NPROJ + C_MLO + cc[k]); }
#pragma unroll
        for (int k = 0; k < 4; ++k) { const f32x4 v = va[k] + vb[k];
            const float rstd = rsqrtf(wave_sum(v.x * v.x + v.y * v.y + v.z * v.z + v.w * v.w) * (1.f / 256.f) + EPS);
            const f32x4 g = *(const f32x4*)(ng + cc[k]);
            u32x2 w; w.x = pk2(sigmoidf_(bflo(oo[k].x)) * v.x * rstd * g.x, sigmoidf_(bfhi(oo[k].x)) * v.y * rstd * g.y);
            w.y = pk2(sigmoidf_(bflo(oo[k].y)) * v.z * rstd * g.z, sigmoidf_(bfhi(oo[k].y)) * v.w * rstd * g.w);
            if (ok[k]) *(u32x2*)(YA + (size_t)mm[k] * 1024 + cc[k]) = w; }
    }
}

namespace da {
using bf16x8 = __attribute__((ext_vector_type(8))) short;
using s16x4  = __attribute__((ext_vector_type(4))) short;
using f32x16 = __attribute__((ext_vector_type(16))) float;
constexpr int KVBLK = 64, LDQ = 1024, LDK = 1024, LDV = NPROJ;
constexpr float SCALE = 0.125f, THR = 8.f;
constexpr int SHM_V = KVBLK * 128 * 2, SHM_K = KVBLK * 128 * 2;
constexpr int NBUF = 4;
constexpr int OFF_WS = NBUF * (SHM_V + SHM_K), OFF_X = 0, OFF_SG = 65536;
#define KSWZ(row, colB) ((row) * 256 + ((colB) ^ (((row) & 7) << 4)))
#define SBAR() __builtin_amdgcn_sched_barrier(0)
__device__ __forceinline__ int crow(int r, int hi) { return (r & 3) + 8 * (r >> 2) + 4 * hi; }
__device__ __forceinline__ unsigned cvtpk(float lo, float hi) { unsigned r; asm volatile("v_cvt_pk_bf16_f32 %0, %1, %2" : "=v"(r) : "v"(lo), "v"(hi)); return r; }
__device__ __forceinline__ void partialSM(f32x16& p0, f32x16& p1, float mnC) {
  constexpr float C = SCALE * 1.4426950408889634f;
#pragma unroll
  for (int r = 0; r < 16; ++r) p0[r] = fmaf(p0[r], C, mnC);
#pragma unroll
  for (int r = 0; r < 16; ++r) p1[r] = fmaf(p1[r], C, mnC);
#pragma unroll
  for (int r = 0; r < 16; ++r) p0[r] = __builtin_amdgcn_exp2f(p0[r]);
}
__device__ __forceinline__ void softmax_tile(f32x16& p0, f32x16& p1, float mnC, float& l_reg, bf16x8& pa0, bf16x8& pa1, bf16x8& pa2, bf16x8& pa3) {
  if (mnC < -28.f) {
#pragma unroll
    for (int r = 0; r < 16; ++r) { p0[r] += mnC; p1[r] += mnC; } }
#pragma unroll
  for (int r = 0; r < 16; ++r) { p0[r] = __builtin_amdgcn_exp2f(p0[r]); p1[r] = __builtin_amdgcn_exp2f(p1[r]); }
  float ps = 0;
#pragma unroll
  for (int r = 0; r < 16; ++r) ps += p0[r] + p1[r];
  { auto rr = __builtin_amdgcn_permlane32_swap(__float_as_uint(ps), __float_as_uint(ps), false, false);
    ps = __uint_as_float(rr[0]) + __uint_as_float(rr[1]); }
  l_reg += ps;
#define PK4(Pv, BASE, OUT) do { unsigned a0 = cvtpk(Pv[BASE + 0], Pv[BASE + 1]), a1 = cvtpk(Pv[BASE + 2], Pv[BASE + 3]);   \
    unsigned b0 = cvtpk(Pv[BASE + 4], Pv[BASE + 5]), b1 = cvtpk(Pv[BASE + 6], Pv[BASE + 7]);                              \
    auto r0 = __builtin_amdgcn_permlane32_swap(a0, b0, false, false); auto r1 = __builtin_amdgcn_permlane32_swap(a1, b1, false, false); \
    u32x4 w = {r0[0], r1[0], r0[1], r1[1]}; OUT = *reinterpret_cast<bf16x8*>(&w); } while (0)
  PK4(p0, 0, pa0); PK4(p0, 8, pa1); PK4(p1, 0, pa2); PK4(p1, 8, pa3);
#undef PK4
}
__device__ __forceinline__ void finishSM(f32x16& p0, f32x16& p1, float& l_reg, bf16x8& pa0, bf16x8& pa1, bf16x8& pa2, bf16x8& pa3) {
#pragma unroll
  for (int r = 0; r < 16; ++r) p1[r] = __builtin_amdgcn_exp2f(p1[r]);
  float ps = 0;
#pragma unroll
  for (int r = 0; r < 16; ++r) ps += p0[r];
#pragma unroll
  for (int r = 0; r < 16; ++r) ps += p1[r];
  { auto rr = __builtin_amdgcn_permlane32_swap(__float_as_uint(ps), __float_as_uint(ps), false, false);
    ps = __uint_as_float(rr[0]) + __uint_as_float(rr[1]); }
  l_reg += ps;
#define PK4(Pv, BASE, OUT) do { unsigned a0 = cvtpk(Pv[BASE + 0], Pv[BASE + 1]), a1 = cvtpk(Pv[BASE + 2], Pv[BASE + 3]);   \
    unsigned b0 = cvtpk(Pv[BASE + 4], Pv[BASE + 5]), b1 = cvtpk(Pv[BASE + 6], Pv[BASE + 7]);                              \
    auto r0 = __builtin_amdgcn_permlane32_swap(a0, b0, false, false); auto r1 = __builtin_amdgcn_permlane32_swap(a1, b1, false, false); \
    u32x4 w = {r0[0], r1[0], r0[1], r1[1]}; OUT = *reinterpret_cast<bf16x8*>(&w); } while (0)
  PK4(p0, 0, pa0); PK4(p0, 8, pa1); PK4(p1, 0, pa2); PK4(p1, 8, pa3);
#undef PK4
}
__device__ __forceinline__ void qkt(f32x16& p0, f32x16& p1, const char* Ks, const bf16x8* qr, int r32, int hi, int comp) {
  p0 = f32x16{}; p1 = f32x16{};
#pragma unroll
  for (int d0 = 0; d0 < 4; ++d0) { const int cb = (comp * 64 + d0 * 16 + hi * 8) * 2;
    bf16x8 b0 = *reinterpret_cast<const bf16x8*>(Ks + KSWZ(r32, cb));
    bf16x8 b1 = *reinterpret_cast<const bf16x8*>(Ks + KSWZ(32 + r32, cb));
    p0 = __builtin_amdgcn_mfma_f32_32x32x16_bf16(b0, qr[d0], p0, 0, 0, 0);
    p1 = __builtin_amdgcn_mfma_f32_32x32x16_bf16(b1, qr[d0], p1, 0, 0, 0); }
}
__device__ __forceinline__ int v_st(int k, int c) { const int kk = (k & ~0xC) | ((k & 4) << 1) | ((k & 8) >> 1); return ((kk >> 3) * 4 + (c >> 5)) * 512 + ((kk & 7) * 32 + (c & 31)) * 2; }
__device__ __forceinline__ int v_rd_base(int lane) { return ((lane & 3) << 3) | (((lane >> 2) & 3) << 6) | (((lane >> 4) & 1) << 5) | (((lane >> 5) & 1) << 8); }
constexpr int v_rd_off(int d0, int ks, int half) { return d0 * 512 + ks * 4096 + half * 2048; }
template <int OFF> __device__ __forceinline__ s16x4 tr_read(int vb) {
  s16x4 r; asm volatile("ds_read_b64_tr_b16 %0, %1 offset:%2" : "=&v"(r) : "v"(vb), "i"(OFF) : "memory"); return r;
}
template <int D0> __device__ __forceinline__ void pv_one(f32x16& od, int vb, bf16x8 pa0, bf16x8 pa1, bf16x8 pa2, bf16x8 pa3) {
  const s16x4 l0 = tr_read<v_rd_off(D0, 0, 0)>(vb), h0 = tr_read<v_rd_off(D0, 0, 1)>(vb), l1 = tr_read<v_rd_off(D0, 1, 0)>(vb), h1 = tr_read<v_rd_off(D0, 1, 1)>(vb);
  const s16x4 l2 = tr_read<v_rd_off(D0, 2, 0)>(vb), h2 = tr_read<v_rd_off(D0, 2, 1)>(vb), l3 = tr_read<v_rd_off(D0, 3, 0)>(vb), h3 = tr_read<v_rd_off(D0, 3, 1)>(vb);
  asm volatile("s_waitcnt lgkmcnt(0)" ::: "memory"); SBAR();
#define PK(Lx, Hx) (bf16x8){Lx[0], Lx[1], Lx[2], Lx[3], Hx[0], Hx[1], Hx[2], Hx[3]}
  od = __builtin_amdgcn_mfma_f32_32x32x16_bf16(pa0, PK(l0, h0), od, 0, 0, 0);
  od = __builtin_amdgcn_mfma_f32_32x32x16_bf16(pa1, PK(l1, h1), od, 0, 0, 0);
  od = __builtin_amdgcn_mfma_f32_32x32x16_bf16(pa2, PK(l2, h2), od, 0, 0, 0);
  od = __builtin_amdgcn_mfma_f32_32x32x16_bf16(pa3, PK(l3, h3), od, 0, 0, 0);
#undef PK
}
__device__ __forceinline__ void pv_d0(f32x16* o, int vb, bf16x8 pa0, bf16x8 pa1, bf16x8 pa2, bf16x8 pa3) {
  s16x4 fa[8], fb[8];
#define PV_RD(f, D0) do { f[0] = tr_read<v_rd_off(D0, 0, 0)>(vb); f[1] = tr_read<v_rd_off(D0, 0, 1)>(vb); f[2] = tr_read<v_rd_off(D0, 1, 0)>(vb); f[3] = tr_read<v_rd_off(D0, 1, 1)>(vb); \
    f[4] = tr_read<v_rd_off(D0, 2, 0)>(vb); f[5] = tr_read<v_rd_off(D0, 2, 1)>(vb); f[6] = tr_read<v_rd_off(D0, 3, 0)>(vb); f[7] = tr_read<v_rd_off(D0, 3, 1)>(vb); } while (0)
#define PV_PK(Lx, Hx) (bf16x8){Lx[0], Lx[1], Lx[2], Lx[3], Hx[0], Hx[1], Hx[2], Hx[3]}
#define PV_MM(od, f) do { od = __builtin_amdgcn_mfma_f32_32x32x16_bf16(pa0, PV_PK(f[0], f[1]), od, 0, 0, 0); od = __builtin_amdgcn_mfma_f32_32x32x16_bf16(pa1, PV_PK(f[2], f[3]), od, 0, 0, 0); \
    od = __builtin_amdgcn_mfma_f32_32x32x16_bf16(pa2, PV_PK(f[4], f[5]), od, 0, 0, 0); od = __builtin_amdgcn_mfma_f32_32x32x16_bf16(pa3, PV_PK(f[6], f[7]), od, 0, 0, 0); } while (0)
  SBAR(); PV_RD(fa, 0); PV_RD(fb, 1);
  asm volatile("s_waitcnt lgkmcnt(8)" ::: "memory"); SBAR(); PV_MM(o[0], fa); SBAR();
  PV_RD(fa, 2); asm volatile("s_waitcnt lgkmcnt(8)" ::: "memory"); SBAR(); PV_MM(o[1], fb); SBAR();
  PV_RD(fb, 3); asm volatile("s_waitcnt lgkmcnt(8)" ::: "memory"); SBAR(); PV_MM(o[2], fa); SBAR();
  asm volatile("s_waitcnt lgkmcnt(0)" ::: "memory"); SBAR(); PV_MM(o[3], fb); SBAR();
#undef PV_RD
#undef PV_PK
#undef PV_MM
}
__device__ __forceinline__ void attn_unit(const bf16* __restrict__ Qb, const bf16* __restrict__ Kh, const bf16* __restrict__ Vh, bf16* __restrict__ Ob, int seq, char* lds,
                                          float lam, float onorm, const float* __restrict__ subg, float mnC) {
  const int tid = tid_(), wid = __builtin_amdgcn_readfirstlane(tid >> 6), lane = tid & 63, r32 = lane & 31, hi = lane >> 5, comp = wid >> 2, wq = wid & 3;
  char* V_lds = lds; char* K_lds = lds + NBUF * SHM_V;
  float* wsl = (float*)(lds + OFF_WS) + wid * 64; float* li_l = wsl;
  float l_reg = 0; f32x16 o[4] = {}; bf16x8 qr[4];
  const bf16* Qw = Qb + (long)(wq * 32 + r32) * LDQ + comp * 64 + hi * 8;
#pragma unroll
  for (int d0 = 0; d0 < 4; ++d0) qr[d0] = *reinterpret_cast<const bf16x8*>(Qw + d0 * 16);
  const int sr = tid >> 4, sc = (tid & 15) * 8, vst0 = v_st(sr, sc), vst1 = v_st(32 + sr, sc);
  const int vb0 = (int)(uintptr_t)V_lds + v_rd_base(lane);
  struct { bf16x8 vs0, vs1, ks0, ks1; } sr_[2];
#define SLOAD(i, k0) do { sr_[i].vs0 = *reinterpret_cast<const bf16x8*>(&Vh[(long)((k0) + sr) * LDV + sc]); sr_[i].vs1 = *reinterpret_cast<const bf16x8*>(&Vh[(long)((k0) + 32 + sr) * LDV + sc]); \
    sr_[i].ks0 = *reinterpret_cast<const bf16x8*>(&Kh[(long)((k0) + sr) * LDK + sc]); sr_[i].ks1 = *reinterpret_cast<const bf16x8*>(&Kh[(long)((k0) + 32 + sr) * LDK + sc]); } while (0)
#define SWRITE(b, i) do { *(bf16x8*)(V_lds + (b) * SHM_V + vst0) = sr_[i].vs0; *(bf16x8*)(V_lds + (b) * SHM_V + vst1) = sr_[i].vs1; const int kc = sc * 2; \
    *(bf16x8*)(K_lds + (b) * SHM_K + KSWZ(sr, kc)) = sr_[i].ks0; *(bf16x8*)(K_lds + (b) * SHM_K + KSWZ(32 + sr, kc)) = sr_[i].ks1; } while (0)
#define SWAIT() asm volatile("s_waitcnt vmcnt(4)" ::: "memory")
#define BARL() asm volatile("s_waitcnt lgkmcnt(0)\n\ts_barrier" ::: "memory")
  f32x16 p0, p1; bf16x8 pa0, pa1, pa2, pa3; const int NTL = seq / KVBLK;
  SLOAD(0, 0); SLOAD(1, KVBLK);
  asm volatile("s_waitcnt vmcnt(4)" ::: "memory"); SWRITE(0, 0);
  asm volatile("s_waitcnt vmcnt(0)" ::: "memory"); SWRITE(1, 1);
  if (2 < NTL) SLOAD(0, 2 * KVBLK);
  if (3 < NTL) SLOAD(1, 3 * KVBLK);
  BARL();
  if (comp == 1) { BARL(); __builtin_amdgcn_s_setprio(1); }
  SBAR(); qkt(p0, p1, K_lds, qr, r32, hi, comp); SBAR();
  BARL();
  for (int j = 0; j < NTL; j += 2) {
    SBAR(); softmax_tile(p0, p1, mnC, l_reg, pa0, pa1, pa2, pa3); SBAR();
    if (j + 2 < NTL) { if (j + 3 < NTL) SWAIT(); else asm volatile("s_waitcnt vmcnt(0)" ::: "memory"); SWRITE((j + 2) & 3, 0); if (j + 4 < NTL) SLOAD(0, (j + 4) * KVBLK); }
    BARL();
    SBAR(); qkt(p0, p1, K_lds + ((j + 1) & 3) * SHM_K, qr, r32, hi, comp);
    pv_d0(o, vb0 + (j & 3) * SHM_V, pa0, pa1, pa2, pa3); SBAR();
    BARL();
    SBAR(); softmax_tile(p0, p1, mnC, l_reg, pa0, pa1, pa2, pa3); SBAR();
    if (j + 3 < NTL) { if (j + 4 < NTL) SWAIT(); else asm volatile("s_waitcnt vmcnt(0)" ::: "memory"); SWRITE((j + 3) & 3, 1); if (j + 5 < NTL) SLOAD(1, (j + 5) * KVBLK); }
    BARL();
    SBAR(); if (j + 2 < NTL) qkt(p0, p1, K_lds + ((j + 2) & 3) * SHM_K, qr, r32, hi, comp);
    pv_d0(o, vb0 + ((j + 1) & 3) * SHM_V, pa0, pa1, pa2, pa3); SBAR();
    if (j + 2 < NTL) BARL();
  }
  if (comp == 0) BARL(); else __builtin_amdgcn_s_setprio(0);
  BARL();
  if (hi == 0) li_l[r32] = l_reg; asm volatile("s_waitcnt lgkmcnt(0)" ::: "memory");
  float rli[16];
#pragma unroll
  for (int r = 0; r < 16; ++r) rli[r] = __builtin_amdgcn_rcpf(li_l[crow(r, hi)]) * (comp ? lam : 1.f);
  float* X = (float*)(lds + OFF_X);
  if (comp == 1) {
#pragma unroll
    for (int r = 0; r < 16; ++r)
#pragma unroll
      for (int d0 = 0; d0 < 4; ++d0) X[(wq * 32 + crow(r, hi)) * 128 + d0 * 32 + r32] = o[d0][r] * rli[r];
  }
  __syncthreads();
  unsigned short* Sg = (unsigned short*)(lds + OFF_SG);
  if (comp == 0) {
    float gsub[4];
#pragma unroll
    for (int d0 = 0; d0 < 4; ++d0) gsub[d0] = subg[d0 * 32 + r32] * onorm;
#pragma unroll
    for (int r = 0; r < 16; ++r) { const int row = wq * 32 + crow(r, hi); float ss = 0.f; float v[4];
#pragma unroll
      for (int d0 = 0; d0 < 4; ++d0) { v[d0] = o[d0][r] * rli[r] - X[row * 128 + d0 * 32 + r32]; ss += v[d0] * v[d0]; }
      ss += xorl<1>(ss); ss += xorl<2>(ss); ss += xorl<4>(ss); ss += xorl<8>(ss); ss += xorl<16>(ss);
      const float rstd = rsqrtf(ss * (1.f / 128.f) + EPS);
#pragma unroll
      for (int d0 = 0; d0 < 4; ++d0) Sg[row * 128 + d0 * 32 + r32] = (unsigned short)f2bf(v[d0] * rstd * gsub[d0]); }
  }
  __syncthreads();
#pragma unroll
  for (int i = 0; i < 4; ++i) { const int c = tid + NT * i, row = c >> 4, cc = c & 15; *(u32x4*)(Ob + (long)row * 1024 + cc * 8) = *(const u32x4*)(Sg + row * 128 + cc * 8); }
  __syncthreads();
#undef SLOAD
#undef SWRITE
#undef SWAIT
#undef BARL
}
#undef KSWZ
#undef SBAR
}
__device__ __forceinline__ void phase_attn(const P& p, int L, unsigned char* lds, int bid, int nblk) { unsigned char* const ws = lp_(p.ws);
    const bf16* PROJ = (const bf16*)(ws + WS_RA + RA_PROJ); const bf16* QN = (const bf16*)(ws + WS_RA + RA_QN); const bf16* KN = (const bf16*)(ws + WS_RA + RA_KN);
    bf16* YC = (bf16*)(ws + WS_RA + RA_YC);
    const float lam_init = 0.8f - 0.6f * expf(-0.3f * (float)L);
    float d1 = 0.f, d2 = 0.f;
    for (int k = 0; k < 64; ++k) { d1 += p.in[I_LQ1][L * 64 + k] * p.in[I_LK1][L * 64 + k]; d2 += p.in[I_LQ2][L * 64 + k] * p.in[I_LK2][L * 64 + k]; }
    const float lam = expf(d1) - expf(d2) + lam_init;
    const float* subg = p.in[I_SUBG] + L * 128;
    float gqm = 0.f, gkm = 0.f;
    for (int k = 0; k < 64; ++k) { gqm = fmaxf(gqm, fabsf(p.in[I_DAQG][L * 64 + k])); gkm = fmaxf(gkm, fabsf(p.in[I_DAKG][L * 64 + k])); }
    const float mnC = -fminf(8.f * gqm * gkm, 30.f) * 1.4426950408889634f;
    unsigned* qctr = (unsigned*)(ws + WS_CTL) + CW_ATTNQ + L * 64; int* qslot = (int*)(lds + LDS_QSLOT);
    for (;;) {
        if (tid_() == 0) *qslot = (int)__hip_atomic_fetch_add(qctr, 1u, __ATOMIC_RELAXED, __HIP_MEMORY_SCOPE_AGENT);
        __syncthreads();
        const int u = *qslot;
        if (u >= (L == DEPTH - 1 ? 512 : 576)) break;
        int bh, n0, seq;
        if (u < 512) { bh = u >> 4; n0 = CTX + (u & 15) * 128; seq = NTOK; } else { const int v = u - 512; bh = v >> 1; n0 = (v & 1) * 128; seq = CTX; }
        const int b = bh >> 3, h = bh & 7; const size_t m0 = (size_t)b * NTOK;
        da::attn_unit(QN + (m0 + n0) * 1024 + h * 128, KN + m0 * 1024 + h * 128, PROJ + m0 * NPROJ + C_DAV + h * 128, YC + (m0 + n0) * 1024 + h * 128, seq, (char*)lds, lam, 1.f - lam_init, subg, mnC);
    }
}

__device__ __forceinline__ void phase_norm2(const P& p, int L, unsigned char* lds, int bid, int nblk, int rmode, int cofs = 0) { unsigned char* const ws = lp_(p.ws);
    const int tid = tid_(), wave = tid >> 6, lane = tid & 63;
    const float* g2 = p.in[I_N2G] + L * DM; const float* rb = p.in[I_RB];
    float* rwt = (float*)lds;
    { const f32x4* src = (const f32x4*)p.in[I_RW];
#pragma unroll 4
      for (int i = 0; i < 16; ++i) { const int id = tid + NT * i, d = id >> 2, q4 = (id & 3) * 4; const f32x4 w = src[id];
          rwt[(q4 + 0) * DM + d] = w.x; rwt[(q4 + 1) * DM + d] = w.y; rwt[(q4 + 2) * DM + d] = w.z; rwt[(q4 + 3) * DM + d] = w.w; }
      __syncthreads(); }
    unsigned* cnt = (unsigned*)(ws + WS_CTL) + CW_MOECNT + L * 1024 + cofs;
    bf16* XG = (bf16*)(ws + WS_RA);
    const int nrows = rmode == 1 ? NB * SEQ : (rmode == 2 ? NB * CTX : MROWS);
    const int rpb = (nrows + nblk - 1) / nblk; int crs = -1; f32x4 cA[8], cB[8];
    for (int r = bid * rpb + wave; r < min(nrows, (bid + 1) * rpb); r += 8) {
        const int m = rmode == 1 ? (r / SEQ) * NTOK + CTX + (r % SEQ) : (rmode == 2 ? (r / CTX) * NTOK + (r % CTX) : r);
        const int rs = __builtin_amdgcn_readfirstlane(row_sel(m));
        if (rs != crs) { crs = rs; const float* md = (const float*)(ws + WS_MOD) + ((size_t)L * 5 + rs) * (6 * DM);
#pragma unroll
            for (int j = 0; j < 8; ++j) { const int c = 4 * lane + 256 * j; cA[j] = *(const f32x4*)(g2 + c) * (*(const f32x4*)(md + 4 * DM + c) + 1.f); cB[j] = *(const f32x4*)(md + 3 * DM + c); } }
        const bf16* z = (const bf16*)(ws + WS_Z) + (size_t)m * DM;
        f32x4 v[8]; float ss = 0.f;
#pragma unroll
        for (int j = 0; j < 8; ++j) { const u32x2 z2 = *(const u32x2*)(z + 4 * lane + 256 * j); v[j] = (f32x4){bflo(z2.x), bfhi(z2.x), bflo(z2.y), bfhi(z2.y)}; ss += v[j].x * v[j].x + v[j].y * v[j].y + v[j].z * v[j].z + v[j].w * v[j].w; }
        const float rstd = rsqrtf(wave_sum(ss) * (1.f / DM) + EPS);
        float lg[16];
#pragma unroll
        for (int e = 0; e < 16; ++e) lg[e] = 0.f;
#pragma unroll
        for (int j = 0; j < 8; ++j) { const int c = 4 * lane + 256 * j;
            v[j] = v[j] * rstd * cA[j] + cB[j];
#pragma unroll
            for (int q = 0; q < 16; ++q) { const f32x4 w4 = *(const f32x4*)(rwt + q * DM + c); lg[q] += v[j].x * w4.x + v[j].y * w4.y + v[j].z * w4.z + v[j].w * w4.w; } }
        { const bool h5 = lane & 32, h4 = lane & 16, h3 = lane & 8, h2 = lane & 4; float r8[8], r4[4], r2[2], r1;
#pragma unroll
          for (int i = 0; i < 8; ++i) { const float keep = h5 ? lg[i + 8] : lg[i], send = h5 ? lg[i] : lg[i + 8]; r8[i] = keep + xor32(send, h5); }
#pragma unroll
          for (int i = 0; i < 4; ++i) { const float keep = h4 ? r8[i + 4] : r8[i], send = h4 ? r8[i] : r8[i + 4]; r4[i] = keep + xorl<16>(send); }
#pragma unroll
          for (int i = 0; i < 2; ++i) { const float keep = h3 ? r4[i + 2] : r4[i], send = h3 ? r4[i] : r4[i + 2]; r2[i] = keep + xorl<8>(send); }
          { const float keep = h2 ? r2[1] : r2[0], send = h2 ? r2[0] : r2[1]; r1 = keep + xorl<4>(send); }
          r1 += xorl<2>(r1); r1 += xorl<1>(r1);
          lg[0] = r1; }
        float score[16], sel[16];
        {
            const float mylg = bperm(lg[0], 4 * (lane & 15)); const float mysc = 1.f / (1.f + expf(-mylg));
#pragma unroll
            for (int e = 0; e < 16; ++e) { score[e] = rdlane(mysc, e); sel[e] = score[e] + rb[e]; } }
        int gi = 0; float gbest = -1e30f;
#pragma unroll
        for (int g = 0; g < 4; ++g) { const float a = sel[4 * g], b = sel[4 * g + 1], c = sel[4 * g + 2], d = sel[4 * g + 3];
            const float hi1 = fmaxf(a, b), lo1 = fminf(a, b), hi2 = fmaxf(c, d), lo2 = fminf(c, d);
            const float top = fmaxf(hi1, hi2), second = fmaxf(fminf(hi1, hi2), (hi1 >= hi2) ? lo1 : lo2);
            const float gs = top + second; if (gs > gbest) { gbest = gs; gi = g; } }
        int e0 = 0, e1 = 0; float b0 = -1e30f, b1 = -1e30f, w0 = 0.f, w1 = 0.f;
#pragma unroll
        for (int e = 0; e < 16; ++e) { const bool in = (e >> 2) == gi; const float sv = sel[e];
            if (in && sv > b0) { b1 = b0; e1 = e0; w1 = w0; b0 = sv; e0 = e; w0 = score[e]; }
            else if (in && sv > b1) { b1 = sv; e1 = e; w1 = score[e]; } }
        const float wsum = w0 + w1; w0 /= wsum; w1 /= wsum;
        unsigned p0 = 0, p1 = 0;
        if (lane == 0) { p0 = atomicAdd(cnt + e0 * 64, 1u); p1 = atomicAdd(cnt + e1 * 64, 1u); }
        p0 = __builtin_amdgcn_readfirstlane(p0); p1 = __builtin_amdgcn_readfirstlane(p1);
        const int s0 = e0 * ECAP + (int)p0, s1 = e1 * ECAP + (int)p1;
        if (lane == 0) { int* rt = (int*)(ws + WS_ROUTE) + (size_t)m * 8; rt[0] = e0; rt[1] = e1; rt[2] = __float_as_int(w0); rt[3] = __float_as_int(w1); rt[4] = s0; rt[5] = s1; }
#pragma unroll
        for (int j = 0; j < 8; ++j) { const int c = 4 * lane + 256 * j; u32x2 w; w.x = pk2(v[j].x, v[j].y); w.y = pk2(v[j].z, v[j].w);
            *(u32x2*)(XG + (size_t)s0 * DM + c) = w; *(u32x2*)(XG + (size_t)s1 * DM + c) = w; }
    }
}

__device__ __forceinline__ void phase_inproj(const P& p, int L, LAS unsigned char* lds, int bid, int nblk) { unsigned char* const ws = lp_(p.ws);
    pg8::Gemm g{(const bf16*)(ws + WS_H), (const bf16*)(ws + WS_WIN + L * SZ_WIN), MROWS, NPADIN, DM}; pg8::StaticOrder S; S.init(MROWS, NPADIN, nblk, bid);
    pg8::EpiInproj E{(bf16*)(ws + WS_RA + RA_PROJ), p.in[I_BIN] + (size_t)L * IN_COLS, (bf16*)(ws + WS_RA + RA_S5A), (bf16*)(ws + WS_RA + RA_QN), (bf16*)(ws + WS_RA + RA_KN),
                      p.in[I_DAQG] + L * 64, p.in[I_DAKG] + L * 64, (const float*)(ws + WS_ROPE), (bf16*)(ws + WS_RA + RA_QK), p.in[I_MLCW] + (size_t)L * 3 * 2048, p.in[I_MLCB] + L * 2048};
    pg8::gemm_phase<pg8::EpiInproj, pg8::StaticOrder, true, true>(lds, g, S, E); }
__device__ __forceinline__ void phase_glu(const P& p, int L, LAS unsigned char* lds, int bid, int nblk) { unsigned char* const ws = lp_(p.ws);
    pg8::Gemm g{(const bf16*)(ws + WS_RA + RA_Z5), (const bf16*)(ws + WS_WGLU + L * SZ_WGLU), MROWS, MIXW, MIXW}; pg8::StaticOrder S; S.init(MROWS, MIXW, nblk, bid);
    pg8::EpiGlu E{(const bf16*)(ws + WS_RA + RA_Z5), (bf16*)(ws + WS_RA + RA_YB), p.in[I_GLUB] + L * MIXW};
    pg8::gemm_phase<pg8::EpiGlu, pg8::StaticOrder, true, true>(lds, g, S, E); }
__device__ __forceinline__ void phase_branch(const P& p, int L, LAS unsigned char* lds, int bid, int nblk, int mode) { unsigned char* const ws = lp_(p.ws);
    pg8::Gemm g{(const bf16*)(ws + WS_RA + RA_YA), (const bf16*)(ws + WS_WBR + L * SZ_WBR), 3 * MROWS, DM, MIXW}; pg8::BranchOrder S; S.T.init(MROWS, DM, nblk, bid, mode);
    pg8::EpiBranch E{(const bf16*)(ws + WS_RA + RA_PROJ) + C_GB, (bf16*)(ws + WS_RA + RA_MGB)};
    pg8::gemm_phase<pg8::EpiBranch, pg8::BranchOrder, true, true>(lds, g, S, E); }
__device__ __forceinline__ void phase_outproj(const P& p, int L, LAS unsigned char* lds, int bid, int nblk, int mode, size_t zofs = WS_Z) { unsigned char* const ws = lp_(p.ws);
    pg8::Gemm g{(const bf16*)(ws + WS_RA + RA_MGB), (const bf16*)(ws + WS_WOUT + L * SZ_WOUT), MROWS, DM, DM}; pg8::StaticOrder S; S.init(MROWS, DM, nblk, bid, mode);
    pg8::EpiOut E{(bf16*)(ws + zofs), (const float*)(ws + WS_MOD) + (size_t)L * 5 * 6 * DM};
    pg8::gemm_phase<pg8::EpiOut, pg8::StaticOrder, true, true>(lds, g, S, E); }
__device__ __forceinline__ void moe_prefix(const P& p, int L, int* pre) { unsigned char* const ws = lp_(p.ws);
    if (tid_() == 0) { const unsigned* cnt = (const unsigned*)(ws + WS_CTL) + CW_MOECNT + L * 1024; int a = 0;
        for (int e = 0; e < 16; ++e) { pre[e] = a; a += (int)((__hip_atomic_load(cnt + e * 64, __ATOMIC_RELAXED, __HIP_MEMORY_SCOPE_AGENT) + 255u) >> 8); } pre[16] = a; }
    __syncthreads();
}
__device__ __forceinline__ void phase_moe_gu(const P& p, int L, LAS unsigned char* lds, int* pre, int bid, int nblk) { unsigned char* const ws = lp_(p.ws);
    pg8::Gemm g{(const bf16*)(ws + WS_RA), (const bf16*)(ws + WS_WGU + L * SZ_WGU), NEXP * ECAP, 2 * DFF, DM}; pg8::MoeOrder S{pre, 4, nblk, bid};
    pg8::EpiGateUp E{(bf16*)(ws + WS_ACT)};
    pg8::gemm_phase<pg8::EpiGateUp, pg8::MoeOrder, true, true>(lds, g, S, E); }
__device__ __forceinline__ void phase_moe_dn(const P& p, int L, LAS unsigned char* lds, int* pre, int bid, int nblk) { unsigned char* const ws = lp_(p.ws);
    pg8::Gemm g{(const bf16*)(ws + WS_ACT), (const bf16*)(ws + WS_WDN + L * SZ_WDN), NEXP * ECAP, DM, DFF}; pg8::MoeOrder S{pre, 8, nblk, bid};
    pg8::EpiPlainBf16 E{(bf16*)(ws + WS_RA), DM};
    pg8::gemm_phase<pg8::EpiPlainBf16, pg8::MoeOrder, true, true>(lds, g, S, E); }

#define XB_TMO      128
#define XB_XCNT(j)  (256  + 64 * (j))
#define XB_XSUB(j)  (1280 + 64 * (j))
#define XB_XGEN(j)  (2304 + 64 * (j))
#define XB_TOP      3328
#define XB_TOPGEN   3392
#define XCD_BAR_WORDS 3456
#define XB_SPIN_CAP (1u << 18)

__device__ __forceinline__ unsigned xb_ld(unsigned* p)              { return __hip_atomic_load(p, __ATOMIC_RELAXED, __HIP_MEMORY_SCOPE_AGENT); }
__device__ __forceinline__ unsigned xb_add(unsigned* p, unsigned v) { return __hip_atomic_fetch_add(p, v, __ATOMIC_RELAXED, __HIP_MEMORY_SCOPE_AGENT); }
__device__ __forceinline__ unsigned xb_xcc_id() { return (unsigned)__builtin_amdgcn_s_getreg((3 << 11) | 20) & 0xFu; }
#define XB_SPIN(cond, bar) do { unsigned _sp = 0; while (cond) { __builtin_amdgcn_s_sleep(1); \
    if ((++_sp & 255u) == 0u) { if (xb_ld(&(bar)[XB_TMO])) break; if (_sp > XB_SPIN_CAP) { atomicAdd(&(bar)[XB_TMO], 1u); break; } } } } while (0)

struct XcdBarrier {
    unsigned* bar; unsigned x;
    volatile LAS unsigned* st;
};

__device__ __forceinline__ XcdBarrier xcd_barrier_post(unsigned* bar, volatile LAS unsigned* st) {
    XcdBarrier b; b.bar = bar; b.x = (unsigned)__builtin_amdgcn_readfirstlane((int)xb_xcc_id()); b.st = st;
    if (threadIdx.x == 0) (void)xb_add(&bar[XB_XCNT(b.x)], 1u);
    return b;
}
__device__ __forceinline__ void xcd_barrier_complete(unsigned* bar, unsigned x, unsigned& nloc, unsigned& nx) {
    const unsigned G = gridDim.x * gridDim.y * gridDim.z;
    unsigned sum, cnt, mine, sp = 0u;
    for (;;) {
        sum = 0u; cnt = 0u; mine = 0u;
#pragma unroll
        for (unsigned j = 0; j < 16; ++j) { const unsigned c = xb_ld(&bar[XB_XCNT(j)]); sum += c; cnt += (c > 0u) ? 1u : 0u; mine = (j == x) ? c : mine; }
        if (sum == G) break;
        __builtin_amdgcn_s_sleep(1);
        if ((++sp & 255u) == 0u) { if (xb_ld(&bar[XB_TMO])) break; if (sp > XB_SPIN_CAP) { atomicAdd(&bar[XB_TMO], 1u); break; } }
    }
    nloc = mine > 0u ? mine : 1u; nx = cnt > 0u ? cnt : 1u;
}

__device__ __forceinline__ void xcd_barrier(const XcdBarrier& b) {
    asm volatile("s_waitcnt vmcnt(0)" ::: "memory");
    __syncthreads();
    if (tid_() == 0) {
        unsigned* bar = lp_(b.bar); unsigned bx = b.x; asm volatile("" : "+s"(bx));
        __builtin_amdgcn_s_waitcnt(0);
        unsigned nloc = b.st[0], nx = b.st[1];
        if (nloc == 0u) { xcd_barrier_complete(bar, bx, nloc, nx); b.st[0] = nloc; b.st[1] = nx; }
        const unsigned old = xb_add(&bar[XB_XSUB(bx)], 1u);
        const unsigned gen = old / nloc;
        if (old + 1u == (gen + 1u) * nloc) {
            __builtin_amdgcn_fence(__ATOMIC_RELEASE, "agent");
            asm volatile("s_waitcnt vmcnt(0)" ::: "memory");
            const unsigned og = xb_add(&bar[XB_TOP], 1u);
            const unsigned tg = og / nx;
            if (og + 1u == (tg + 1u) * nx) xb_add(&bar[XB_TOPGEN], 1u);
            else XB_SPIN(xb_ld(&bar[XB_TOPGEN]) == tg, bar);
            __builtin_amdgcn_fence(__ATOMIC_ACQUIRE, "agent");
            xb_add(&bar[XB_XGEN(bx)], 1u);
            asm volatile("s_waitcnt vmcnt(0)" ::: "memory");
        } else {
            XB_SPIN(xb_ld(&bar[XB_XGEN(bx)]) == gen, bar);
            __builtin_amdgcn_fence(__ATOMIC_ACQUIRE, "agent");
            asm volatile("s_waitcnt vmcnt(0)" ::: "memory");
        }
    }
    __syncthreads();
}

constexpr int CW_BAR = 4096;
static_assert(CW_BAR + XCD_BAR_WORDS <= CW_ATTNQ && CW_ATTNQ + DEPTH * 64 <= CW_MOECNT, "control word map");
constexpr int LDS_BYTES = 147456;
constexpr int LDS_MISC = 143360;
__global__ void __launch_bounds__(NT, 2) mk_fwd(P p) {
    extern __shared__ __attribute__((aligned(16))) unsigned char lds_[];
    LAS unsigned char* lds = (LAS unsigned char*)lds_;
    const int bid = blockIdx.x, nblk = gridDim.x;
    for (int u = threadIdx.x; u < (LDS_BYTES - LDS_MISC) / 4; u += NT) ((LAS unsigned*)(lds + LDS_MISC))[u] = 0u;
    __syncthreads();
    static_assert(LDS_TIDTAB == LDS_MISC + 1024, "tid table sits in the LDS misc region");
    if ((threadIdx.x & 63) == 0) *(LAS int*)(lds + LDS_TIDTAB + ((unsigned)__builtin_amdgcn_s_getreg((6 << 11) | 4) & 63u) * 4) = (int)(threadIdx.x >> 6);
    __syncthreads();
    int* pre = (int*)(lds_ + LDS_MISC);
    XcdBarrier bar = xcd_barrier_post((unsigned*)(p.ws + WS_CTL) + CW_BAR, (volatile LAS unsigned*)(lds + LDS_MISC + 256));
    phase_prologue(p, lds_, bid, nblk);
    xcd_barrier(bar);
    prologue_s5tables(p, lds_, bid, nblk);
    if (PROBE_DUP == 10) prologue_s5tables(p, lds_, bid, nblk);
    xcd_barrier(bar);
    if (PROBE_DUP == 17) { phase_prologue(p, lds_, bid, nblk); xcd_barrier(bar); prologue_s5tables(p, lds_, bid, nblk); xcd_barrier(bar); }
    for (int L = 0; L < DEPTH; ++L) {
        phase_norm1(p, L, lds_, bid, nblk);
        if (PROBE_DUP == 15) { __syncthreads(); phase_norm1<true>(p, L, lds_, bid, nblk); }
        xcd_barrier(bar);
        phase_inproj(p, L, lds, bid, nblk);
        const int fb = IT_P + L * IT_T;
        if (nblk == 256) prologue_transposes(p, lds_, bid, fb, fb + IT_FI, 224, 32);
        if (PROBE_DUP == 2) phase_inproj(p, L, lds, bid, nblk);
        xcd_barrier(bar);
        phase_mlconv(p, L, bid, nblk); phase_s5_gemm1(p, L, lds, bid, nblk);
        if (PROBE_DUP == 8) { phase_mlconv(p, L, bid, nblk); }
        if (PROBE_DUP == 9) phase_s5_gemm1(p, L, lds, bid, nblk);
        xcd_barrier(bar);
        phase_s5_scan(p, L, bid, nblk); phase_mlstm(p, L, lds, bid, nblk); phase_attn(p, L, lds_, bid, nblk);
        if (PROBE_DUP == 3) phase_attn(p, L, lds_, bid, nblk);
        if (PROBE_DUP == 18) phase_s5_scan(p, L, bid, nblk);
        if (PROBE_DUP == 4) phase_mlstm(p, L, lds, bid, nblk);
        xcd_barrier(bar);
        phase_s5_gemm2(p, L, lds, bid, nblk); phase_mlpost(p, L, bid, nblk);
        if (PROBE_DUP == 9) phase_s5_gemm2(p, L, lds, bid, nblk);
        if (PROBE_DUP == 8) phase_mlpost(p, L, bid, nblk);
        xcd_barrier(bar);
        phase_glu(p, L, lds, bid, nblk);
        if (nblk == 256) prologue_transposes(p, lds_, bid, fb + IT_FI, fb + IT_FI + IT_F0, 144, 112);
        if (PROBE_DUP == 12) phase_glu(p, L, lds, bid, nblk);
        xcd_barrier(bar);
        if (L == DEPTH - 1 || nblk != 256) {
            const int md = L == DEPTH - 1 ? 1 : 0;
            phase_branch(p, L, lds, bid, nblk, md);
            xcd_barrier(bar);
            phase_outproj(p, L, lds, bid, nblk, md);
            xcd_barrier(bar);
            phase_norm2(p, L, lds_, bid, nblk, md);
            xcd_barrier(bar);
        } else {
            phase_branch(p, L, lds, bid, nblk, 1);
            xcd_barrier(bar);
            if (bid < 32) phase_branch(p, L, lds, bid, 32, 2);
            else { phase_outproj(p, L, lds, bid - 32, 224, 1);
                   prologue_transposes(p, lds_, bid, fb + IT_FI + IT_F0, fb + IT_FI + IT_F1, 64, 192); }
            xcd_barrier(bar);
            if (bid < 32) phase_outproj(p, L, lds, bid, 32, 2);
            else phase_norm2(p, L, lds_, bid - 32, 224, 1);
            xcd_barrier(bar);
            phase_norm2(p, L, lds_, bid, nblk, 2);
            xcd_barrier(bar);
        }
        moe_prefix(p, L, pre);
        phase_moe_gu(p, L, lds, pre, bid, nblk);
        if (nblk == 256) { const int tot = pre[16] * 4, b0 = tot > 256 ? min(tot - 256, 256) : 0;
            const int g0 = fb + IT_FI + (L + 1 < DEPTH ? IT_F1 : IT_F0), g1 = L + 1 < DEPTH ? fb + IT_T : fb + IT_SH;
            if (tot <= 512) prologue_transposes(p, lds_, bid, g0, g1, b0, 256 - b0); else { __syncthreads(); prologue_transposes(p, lds_, bid, g0, g1, 0, 256); } }
        if (PROBE_DUP == 6) phase_moe_gu(p, L, lds, pre, bid, nblk);
        xcd_barrier(bar);
        phase_moe_dn(p, L, lds, pre, bid, nblk);
        if (PROBE_DUP == 7) phase_moe_dn(p, L, lds, pre, bid, nblk);
        xcd_barrier(bar);
    }
    phase_final(p, bid, nblk);
}

extern "C" void kernel_launch(void* const* d_in, const int* in_sizes, int n_in, void* d_out, int out_size, void* d_ws, size_t ws_size, hipStream_t stream) {
    static int grid = 0;
    if (grid == 0) {
        if (n_in != 37 || ws_size < WS_END || out_size != NB * SEQ * DM) { fprintf(stderr, "kernel_launch: unexpected shapes (n_in %d, ws %zu < %zu?, out %d)\n", n_in, ws_size, (size_t)WS_END, out_size); grid = -1; return; }
        int dev = 0, cus = 0, per_cu = 0; (void)hipGetDevice(&dev); (void)hipDeviceGetAttribute(&cus, hipDeviceAttributeMultiprocessorCount, dev);
        if (hipFuncSetAttribute((const void*)mk_fwd, hipFuncAttributeMaxDynamicSharedMemorySize, LDS_BYTES) != hipSuccess) { fprintf(stderr, "hipFuncSetAttribute failed\n"); grid = -1; return; }
        if (hipOccupancyMaxActiveBlocksPerMultiprocessor(&per_cu, (const void*)mk_fwd, NT, LDS_BYTES) != hipSuccess || per_cu < 1) { fprintf(stderr, "occupancy query: %d blocks per CU\n", per_cu); (void)hipGetLastError(); }
        grid = cus > 0 ? cus : 256;
    }
    if (grid < 0) return;
    (void)hipMemsetAsync((char*)d_ws + WS_CTL, 0, 1 * MiB, stream);
    P p{}; for (int i = 0; i < 37; ++i) p.in[i] = (const float*)d_in[i]; p.out = (float*)d_out; p.ws = (unsigned char*)d_ws; p.layer = 0; p.pad = 0;
    hipLaunchKernelGGL(mk_fwd, dim3(grid), dim3(NT), LDS_BYTES, stream, p);
    const hipError_t le = hipPeekAtLastError();
    if (le != hipSuccess) fprintf(stderr, "kernel_launch: launch failed: %s\n", hipGetErrorName(le));
}
```

```cpp
#include <hip/hip_runtime.h>
#include <cstdio>
#include <cstdint>
#ifndef PROBE_DUP
#define PROBE_DUP 0
#endif
template <class T> __device__ __forceinline__ T* lp_(T* x) { asm volatile("" : "+s"(x)); return x; }
constexpr int LDS_TIDTAB = 143360 + 1024;
constexpr int LDS_QSLOT = 143360 + 512;
__device__ __forceinline__ int tid_() {
    const unsigned key = (unsigned)__builtin_amdgcn_s_getreg((6 << 11) | 4) & 63u;
    const int wv = __builtin_amdgcn_readfirstlane(*(const __attribute__((address_space(3))) int*)(uintptr_t)(LDS_TIDTAB + key * 4));
    int t = wv * 64 + (int)__builtin_amdgcn_mbcnt_hi(~0u, __builtin_amdgcn_mbcnt_lo(~0u, 0u)); asm volatile("" : "+v"(t)); return t; }
namespace pg8 {
#define PG8_LAS __attribute__((address_space(3)))
typedef unsigned short bf16_t;
typedef short bf16x8 __attribute__((ext_vector_type(8)));
typedef float f32x4 __attribute__((ext_vector_type(4)));
typedef unsigned u32x4 __attribute__((ext_vector_type(4)));
constexpr int BM = 256, BK = 64, HALF = 128, HTB = HALF * BK * 2  , STAGE_BYTES = 8 * HTB, NXCD = 8, WGM = 8;

__host__ __device__ __forceinline__ int lds_byte(int r, int c) { const int st = (r >> 4) * 2 + (c >> 5), rr = r & 15, cc = c & 31, ob = rr * 64 + cc * 2; return st * 1024 + (ob ^ (((ob >> 9) & 1) << 5)); }
__host__ __device__ __forceinline__ void stage_rc(int b, int& R, int& C) { const int st = b / 1024, sb = b % 1024, swz = sb ^ (((sb >> 9) & 1) << 5); R = (st >> 1) * 16 + swz / 64; C = (st & 1) * 32 + (swz % 64) / 2; }
__host__ __device__ __forceinline__ int perm32(int rho) { const int n = rho >> 4, i = rho & 15; return 8 * (i >> 2) + 4 * n + (i & 3); }

struct Unit { int pm, pn, pb, pa, pr; };
struct Gemm { const bf16_t* A; const bf16_t* Bt; int M, N, K; int lda = 0; };

struct StaticOrder {
    int nM, nN, nwg, G, c, lat;
    __host__ __device__ void init(int M, int N, int G_, int c_, int lat_ = 0) { lat = lat_; nM = lat == 1 ? (M / BM) / 9 * 8 : (lat == 2 ? (M / BM) / 9 : M / BM); nN = N / BM; nwg = nM * nN; G = G_; c = c_; }
    __host__ __device__ bool next(int i, Unit& u) const {
        const long L = (long)i * G + c; if (L >= nwg) return false;
        int wgid = (int)L; { const int q = nwg / NXCD, r = nwg % NXCD, xcd = wgid % NXCD, off = wgid / NXCD; wgid = (xcd < r ? xcd * (q + 1) : r * (q + 1) + (xcd - r) * q) + off; }
        const int nig = WGM * nN, gid = wgid / nig, fm = gid * WGM, gsz = (nM - fm) < WGM ? (nM - fm) : WGM;
        u.pm = fm + ((wgid % nig) % gsz); if (lat == 1) u.pm = (u.pm >> 3) * 9 + 1 + (u.pm & 7); else if (lat == 2) u.pm = u.pm * 9; u.pn = (wgid % nig) / gsz; u.pb = u.pn; u.pa = u.pm; u.pr = 0; return true;
    }
    __device__ __forceinline__ void a_ready(const Unit&) const {}
    __device__ __forceinline__ void done(const Unit&) const {}
};

typedef __bf16 cvt_bf16x2 __attribute__((ext_vector_type(2))); typedef float cvt_f32x2 __attribute__((ext_vector_type(2)));
__device__ __forceinline__ unsigned cvt_pk_bf16(float lo, float hi) { const cvt_f32x2 f = {lo, hi}; const cvt_bf16x2 h = __builtin_convertvector(f, cvt_bf16x2); return __builtin_bit_cast(unsigned, h); }
template <class Epi, class Sched, bool ALIGN_EPI = false, bool SP2 = false>
__device__ __forceinline__ void gemm_phase(PG8_LAS unsigned char* lds, const Gemm g, const Sched& S, const Epi& E) {
    const int tid = tid_(), wid = __builtin_amdgcn_readfirstlane(tid >> 6), lane = tid & 63, wr = wid >> 2, wc = wid & 3, fr = lane & 15, fq = lane >> 4;
    const int K = g.K, nt = K / BK, lda = g.lda ? g.lda : g.K;
    unsigned voffA[2], voffB[2];
#pragma unroll
    for (int i = 0; i < 2; ++i) { int R, C; stage_rc(tid * 16 + i * 8192, R, C); const int Rb = Epi::PERM ? ((R & ~31) + perm32(R & 31)) : R;
        voffA[i] = (unsigned)(R * lda + C) * 2u; voffB[i] = (unsigned)(Rb * K + C) * 2u; }
    const size_t kstep = (size_t)(BK * 2);
    const size_t hstep = (size_t)HALF * K * 2;
    const size_t tstep = 2 * hstep;
    const size_t hstepA = (size_t)HALF * lda * 2, tstepA = 2 * hstepA;
    const unsigned ldsw = (unsigned)wid * 1024u;
    const int aoff = lds_byte(wr * 64 + fr, fq * 8), boff = lds_byte(wc * 32 + fr, fq * 8);
#define PG8_SA(b, h) (((b) * 2 + (h)) * HTB)
#define PG8_SB(b, h) ((4 + (b) * 2 + (h)) * HTB)
#define PG8_STAGE(bufoff, gbase, voff) do { _Pragma("unroll") for (int _i = 0; _i < 2; ++_i) \
        __builtin_amdgcn_global_load_lds((const unsigned*)((const char*)(gbase) + (voff)[_i]), (PG8_LAS unsigned*)(lds + (bufoff) + ldsw + _i * 8192), 16, 0, 0); } while (0)
#define PG8_LDA(dst, b, h) do { _Pragma("unroll") for (int m = 0; m < 4; ++m) _Pragma("unroll") for (int k = 0; k < 2; ++k) dst[m][k] = *(const PG8_LAS bf16x8*)(lds + PG8_SA(b, h) + aoff + m * 2048 + k * 1024); } while (0)
#define PG8_LDB(dst, b, h) do { _Pragma("unroll") for (int n = 0; n < 2; ++n) _Pragma("unroll") for (int k = 0; k < 2; ++k) dst[n][k] = *(const PG8_LAS bf16x8*)(lds + PG8_SB(b, h) + boff + n * 2048 + k * 1024); } while (0)
#define PG8_MMA(ai, bj, At, Bt) do { __builtin_amdgcn_s_setprio(1); _Pragma("unroll") for (int m = 0; m < 4; ++m) _Pragma("unroll") for (int n = 0; n < 2; ++n) _Pragma("unroll") for (int k = 0; k < 2; ++k) \
        acc[ai][bj][m][n] = __builtin_amdgcn_mfma_f32_16x16x32_bf16(Bt[n][k], At[m][k], acc[ai][bj][m][n], 0, 0, 0); __builtin_amdgcn_s_setprio(0); } while (0)
#define PG8_WAIT_V(n) asm volatile("s_waitcnt vmcnt(" #n ")" ::: "memory")
#define PG8_WAIT_L(n) asm volatile("s_waitcnt lgkmcnt(" #n ")" ::: "memory")
#define PG8_BAR __builtin_amdgcn_s_barrier()
#define PG8_SCHED __builtin_amdgcn_sched_barrier(0)
    Unit cur, nxt; int ui = 0;
    if (!S.next(0, cur)) return;
    f32x4 acc[2][2][4][2];
#pragma unroll
    for (int a = 0; a < 2; ++a)
#pragma unroll
        for (int b = 0; b < 2; ++b)
#pragma unroll
            for (int m = 0; m < 4; ++m)
#pragma unroll
                for (int n = 0; n < 2; ++n) acc[a][b][m][n] = (f32x4){0.f, 0.f, 0.f, 0.f};
    bf16x8 At[4][2], B0[2][2], B1[2][2];
    const char* cA = (const char*)g.A + (size_t)cur.pa * tstepA; const char* cB = (const char*)g.Bt + (size_t)cur.pb * tstep;
    S.a_ready(cur);
    if constexpr (SP2) {
        PG8_STAGE(PG8_SB(0, 0), cB, voffB); PG8_STAGE(PG8_SB(0, 1), cB + hstep, voffB); PG8_STAGE(PG8_SA(0, 0), cA, voffA); PG8_STAGE(PG8_SA(0, 1), cA + hstepA, voffA);
        if (wr == 1) PG8_BAR;
        PG8_WAIT_V(2); PG8_BAR;
        PG8_STAGE(PG8_SB(1, 0), cB + kstep, voffB); PG8_STAGE(PG8_SA(1, 0), cA + kstep, voffA); PG8_STAGE(PG8_SB(1, 1), cB + hstep + kstep, voffB);
        PG8_WAIT_V(6); PG8_BAR;
    } else {
        PG8_STAGE(PG8_SB(0, 0), cB, voffB); PG8_STAGE(PG8_SA(0, 0), cA, voffA); PG8_STAGE(PG8_SB(0, 1), cB + hstep, voffB); PG8_STAGE(PG8_SA(0, 1), cA + hstepA, voffA);
        if (wr == 1) PG8_BAR;
        PG8_WAIT_V(4); PG8_BAR;
        PG8_STAGE(PG8_SB(1, 0), cB + kstep, voffB); PG8_STAGE(PG8_SA(1, 0), cA + kstep, voffA); PG8_STAGE(PG8_SB(1, 1), cB + hstep + kstep, voffB);
        PG8_WAIT_V(6); PG8_BAR;
    }
    for (;;) {
        const bool has_next = S.next(ui + 1, nxt);
        const char* nA = has_next ? (const char*)g.A + (size_t)nxt.pa * tstepA : cA; const char* nB = has_next ? (const char*)g.Bt + (size_t)nxt.pb * tstep : cB;
        for (int t = 0; t < nt; t += 2) {
            const bool last = (t == nt - 2);
            const char* a1 = cA + (size_t)(t + 1) * kstep;
            const char* a2 = last ? nA : cA + (size_t)(t + 2) * kstep; const char* b2 = last ? nB : cB + (size_t)(t + 2) * kstep;
            const char* a3 = a2 + kstep; const char* b3 = b2 + kstep;
            if (last && has_next) S.a_ready(nxt);
            if constexpr (SP2) {
            PG8_LDB(B0, 0, 0); PG8_LDB(B1, 0, 1); PG8_SCHED; PG8_LDA(At, 0, 0); PG8_STAGE(PG8_SA(1, 1), a1 + hstepA, voffA);
            PG8_WAIT_V(8); PG8_WAIT_L(0); PG8_BAR; PG8_MMA(0, 0, At, B0); PG8_MMA(0, 1, At, B1); PG8_BAR; PG8_SCHED;
            PG8_LDA(At, 0, 1); PG8_STAGE(PG8_SB(0, 0), b2, voffB); PG8_STAGE(PG8_SB(0, 1), b2 + hstep, voffB); PG8_STAGE(PG8_SA(0, 0), a2, voffA);
            PG8_WAIT_V(8); PG8_WAIT_L(0); PG8_BAR; PG8_MMA(1, 0, At, B0); PG8_MMA(1, 1, At, B1); PG8_BAR; PG8_SCHED;
            PG8_LDB(B0, 1, 0); PG8_LDB(B1, 1, 1); PG8_SCHED; PG8_LDA(At, 1, 0); PG8_STAGE(PG8_SA(0, 1), a2 + hstepA, voffA);
            PG8_WAIT_V(8); PG8_WAIT_L(0); PG8_BAR; PG8_MMA(0, 0, At, B0); PG8_MMA(0, 1, At, B1); PG8_BAR; PG8_SCHED;
            PG8_LDA(At, 1, 1); PG8_STAGE(PG8_SB(1, 0), b3, voffB); PG8_STAGE(PG8_SB(1, 1), b3 + hstep, voffB); PG8_STAGE(PG8_SA(1, 0), a3, voffA);
            PG8_WAIT_V(8); PG8_WAIT_L(0); PG8_BAR; PG8_MMA(1, 0, At, B0); PG8_MMA(1, 1, At, B1); PG8_BAR; PG8_SCHED;
            } else {
            PG8_LDB(B0, 0, 0); PG8_SCHED; PG8_LDA(At, 0, 0); PG8_STAGE(PG8_SA(1, 1), a1 + hstepA, voffA);
            PG8_WAIT_L(8); PG8_BAR; PG8_WAIT_L(0); PG8_MMA(0, 0, At, B0); PG8_BAR; PG8_SCHED;
            PG8_LDB(B1, 0, 1); PG8_STAGE(PG8_SB(0, 0), b2, voffB);
            PG8_BAR; PG8_WAIT_L(0); PG8_MMA(0, 1, At, B1); PG8_BAR;
            PG8_LDA(At, 0, 1); PG8_STAGE(PG8_SA(0, 0), a2, voffA);
            PG8_BAR; PG8_WAIT_L(0); PG8_MMA(1, 0, At, B0); PG8_BAR; PG8_SCHED;
            PG8_STAGE(PG8_SB(0, 1), b2 + hstep, voffB);
            PG8_WAIT_V(6); PG8_BAR; PG8_MMA(1, 1, At, B1); PG8_BAR;
            PG8_LDB(B0, 1, 0); PG8_SCHED; PG8_LDA(At, 1, 0); PG8_STAGE(PG8_SA(0, 1), a2 + hstepA, voffA);
            PG8_WAIT_L(8); PG8_BAR; PG8_WAIT_L(0); PG8_MMA(0, 0, At, B0); PG8_BAR; PG8_SCHED;
            PG8_LDB(B1, 1, 1); PG8_STAGE(PG8_SB(1, 0), b3, voffB);
            PG8_BAR; PG8_WAIT_L(0); PG8_MMA(0, 1, At, B1); PG8_BAR;
            PG8_LDA(At, 1, 1); PG8_STAGE(PG8_SA(1, 0), a3, voffA);
            PG8_BAR; PG8_WAIT_L(0); PG8_MMA(1, 0, At, B0); PG8_BAR; PG8_SCHED;
            PG8_STAGE(PG8_SB(1, 1), b3 + hstep, voffB);
            PG8_WAIT_V(6); PG8_BAR; PG8_MMA(1, 1, At, B1); PG8_BAR;
            }
        }
        if constexpr (ALIGN_EPI) { if (wr == 0) PG8_BAR; }
        if constexpr (!Epi::AFTER_DRAIN) { int le = (int)__builtin_amdgcn_mbcnt_hi(~0u, __builtin_amdgcn_mbcnt_lo(~0u, 0u)); asm volatile("" : "+v"(le));
            E(acc, cur, wr, wc, le & 15, le >> 4); S.done(cur); }
        if (!has_next) break;
        if (!Epi::KEEP || nxt.pr == 0) {
#pragma unroll
        for (int a = 0; a < 2; ++a)
#pragma unroll
            for (int b = 0; b < 2; ++b)
#pragma unroll
                for (int m = 0; m < 4; ++m)
#pragma unroll
                    for (int n = 0; n < 2; ++n) acc[a][b][m][n] = (f32x4){0.f, 0.f, 0.f, 0.f};
        }
        cur = nxt; cA = nA; cB = nB; ++ui;
        if constexpr (ALIGN_EPI) { if (wr == 1) PG8_BAR; }
    }
    PG8_WAIT_V(0);
    if constexpr (!ALIGN_EPI) { if (wr == 0) PG8_BAR; }
    PG8_BAR;
    if constexpr (Epi::AFTER_DRAIN) { E.fused(acc, cur, wr, wc, fr, fq, lds, wid, lane); S.done(cur); }
#undef PG8_SA
#undef PG8_SB
#undef PG8_STAGE
#undef PG8_LDA
#undef PG8_LDB
#undef PG8_MMA
#undef PG8_WAIT_V
#undef PG8_WAIT_L
#undef PG8_BAR
#undef PG8_SCHED
}
}

typedef unsigned short bf16;
typedef float f32x4 __attribute__((ext_vector_type(4)));
typedef unsigned u32x4 __attribute__((ext_vector_type(4)));
typedef unsigned u32x2 __attribute__((ext_vector_type(2)));
#define LAS __attribute__((address_space(3)))
constexpr int DM = 2048, NB = 4, SEQ = 2048, DEPTH = 4, CTX = 256, NTOK = CTX + SEQ, MROWS = NB * NTOK;
constexpr int MIXW = 1024, IN_COLS = 14352, NPROJ = 14336, NPADIN = 14336;
constexpr int C_MLQ = 0, C_MLK = 1024, C_MLV = 2048, C_MLO = 3072, C_S5U = 4096, C_DAQ = 5120, C_DAK = 6144, C_DAV = 7168, C_GB = 8192;
constexpr int NEXP = 16, DFF = 512, ECAP = MROWS;
constexpr float EPS = 1e-6f;
constexpr int NT = 512;

constexpr size_t MiB = 1u << 20;
constexpr size_t al1(size_t x) { return (x + MiB - 1) / MiB * MiB; }
constexpr size_t WS_CTL = 0;
constexpr size_t WS_MOD = 1 * MiB;
constexpr size_t WS_S5P = 2 * MiB, S5P_STRIDE = 2 * MiB;
constexpr size_t WS_ROPE = 10 * MiB;
constexpr size_t WS_ROUTE = 11 * MiB;
constexpr size_t WS_GATES = 12 * MiB;
constexpr size_t WS_WG = 13 * MiB;
constexpr size_t WS_S5E = 14 * MiB;
constexpr size_t WS_S5C = 23 * MiB;
constexpr size_t WS_WIN = 33 * MiB;
constexpr size_t SZ_WIN = (size_t)NPADIN * DM * 2;
constexpr size_t WS_WGLU = al1(WS_WIN + DEPTH * SZ_WIN);
constexpr size_t SZ_WGLU = (size_t)MIXW * MIXW * 2;
constexpr size_t WS_WBR = al1(WS_WGLU + DEPTH * SZ_WGLU);
constexpr size_t SZ_WBR = (size_t)3 * DM * MIXW * 2;
constexpr size_t WS_WOUT = al1(WS_WBR + DEPTH * SZ_WBR);
constexpr size_t SZ_WOUT = (size_t)DM * DM * 2;
constexpr size_t WS_WGU = al1(WS_WOUT + DEPTH * SZ_WOUT);
constexpr size_t SZ_WGU = (size_t)NEXP * 2 * DFF * DM * 2;
constexpr size_t WS_WDN = al1(WS_WGU + DEPTH * SZ_WGU);
constexpr size_t SZ_WDN = (size_t)NEXP * DM * DFF * 2;
constexpr size_t WS_S5T1 = al1(WS_WDN + DEPTH * SZ_WDN);
constexpr size_t SZ_S5T1 = (size_t)64 * 256 * 256 * 2;
constexpr size_t WS_S5T2 = al1(WS_S5T1 + DEPTH * SZ_S5T1);
constexpr size_t SZ_S5T2 = (size_t)64 * 256 * 512 * 2;
constexpr size_t WS_Z = al1(WS_S5T2 + DEPTH * SZ_S5T2);
constexpr size_t WS_H = al1(WS_Z + (size_t)MROWS * DM * 4);
constexpr size_t WS_ACT = al1(WS_H + (size_t)MROWS * DM * 2);
constexpr size_t WS_RA = al1(WS_ACT + (size_t)NEXP * ECAP * DFF * 2);
constexpr size_t RA_PROJ = 0;
constexpr size_t RA_QK = al1(RA_PROJ + (size_t)MROWS * NPROJ * 2);
constexpr size_t RA_HML = al1(RA_QK + (size_t)MROWS * 2048 * 2);
constexpr size_t RA_YA = al1(RA_HML + (size_t)2 * MROWS * 1024 * 4);
constexpr size_t RA_YB = RA_YA + (size_t)MROWS * 1024 * 2, RA_YC = RA_YB + (size_t)MROWS * 1024 * 2;
constexpr int S5ROWS = 768;
constexpr size_t RA_S5E = al1(RA_YC + (size_t)MROWS * 1024 * 2);
constexpr size_t RA_S5A = al1(RA_S5E + (size_t)64 * S5ROWS * 256 * 4);
constexpr size_t RA_Z5 = al1(RA_S5A + (size_t)64 * S5ROWS * 512 * 2);
constexpr size_t RA_QN = al1(RA_Z5 + (size_t)MROWS * 1024 * 2);
constexpr size_t RA_KN = al1(RA_QN + (size_t)MROWS * 1024 * 2);
constexpr size_t RA_MGB = al1(RA_KN + (size_t)MROWS * 1024 * 2);
constexpr size_t RA_END = al1(RA_MGB + (size_t)MROWS * DM * 2);
constexpr size_t SZ_XG = (size_t)NEXP * ECAP * DM * 2;
constexpr size_t WS_END = WS_RA + (RA_END > SZ_XG ? RA_END : SZ_XG);
static_assert(WS_END < 1940000000ull, "workspace map exceeds the guaranteed d_ws size (sum of inputs = 1.947e9 bytes)");
constexpr int CW_ATTNQ = 7680;
constexpr int CW_MOECNT = 8192;

typedef __bf16 hbf16x2 __attribute__((ext_vector_type(2))); typedef float hf32x2 __attribute__((ext_vector_type(2)));
__device__ __forceinline__ unsigned pk2(float lo, float hi) { const hf32x2 f = {lo, hi}; const hbf16x2 h = __builtin_convertvector(f, hbf16x2); return __builtin_bit_cast(unsigned, h); }
__device__ __forceinline__ unsigned f2bf(float f) { return pk2(f, 0.f); }
__device__ __forceinline__ float bf2f(bf16 h) { return __uint_as_float(((unsigned)h) << 16); }
__device__ __forceinline__ float bflo(unsigned w) { return __uint_as_float(w << 16); }
__device__ __forceinline__ float bfhi(unsigned w) { return __uint_as_float(w & 0xffff0000u); }
template <int CTRL, int ROWMASK = 0xF> __device__ __forceinline__ float dppf(float old, float x) { return __int_as_float(__builtin_amdgcn_update_dpp(__float_as_int(old), __float_as_int(x), CTRL, ROWMASK, 0xF, false)); }
template <int K> __device__ __forceinline__ float xorl(float x) {
    if constexpr (K == 1) return dppf<0xB1>(x, x); else if constexpr (K == 2) return dppf<0x4E>(x, x); else if constexpr (K == 8) return dppf<0x128>(x, x);
    else return __int_as_float(__builtin_amdgcn_ds_swizzle(__float_as_int(x), (K << 10) | 0x1F)); }
__device__ __forceinline__ float xor32(float x, bool upper) { const auto rr = __builtin_amdgcn_permlane32_swap(__float_as_uint(x), __float_as_uint(x), false, false); return __uint_as_float(upper ? rr[0] : rr[1]); }
__device__ __forceinline__ float bperm(float x, int srclane) { return __int_as_float(__builtin_amdgcn_ds_bpermute(srclane << 2, __float_as_int(x))); }
__device__ __forceinline__ float rdlane(float x, int k) { return __int_as_float(__builtin_amdgcn_readlane(__float_as_int(x), k)); }
__device__ __forceinline__ float wave_sum(float v) {
    v += xorl<1>(v); v += xorl<2>(v); v += xorl<4>(v); v += xorl<8>(v); v += xorl<16>(v);
    const auto rr = __builtin_amdgcn_permlane32_swap(__float_as_uint(v), __float_as_uint(v), false, false); return __uint_as_float(rr[0]) + __uint_as_float(rr[1]);
}
template <bool MAX> __device__ __forceinline__ float wave_scan(float x) {
    const float ID = MAX ? -3.0e38f : 0.f;
#define SC_(CTRL, RM) { const float t = dppf<CTRL, RM>(ID, x); x = MAX ? fmaxf(x, t) : x + t; }
    SC_(0x111, 0xF) SC_(0x112, 0xF) SC_(0x114, 0xF) SC_(0x118, 0xF) SC_(0x142, 0xA) SC_(0x143, 0xC)
#undef SC_
    return x;
}
__device__ __forceinline__ float sigmoidf_(float x) { return __builtin_amdgcn_rcpf(1.f + __expf(-x)); }
__device__ __forceinline__ float siluf_(float x) { return x * __builtin_amdgcn_rcpf(1.f + __expf(-x)); }
__device__ __forceinline__ float gelu_tanh(float x) { const float u = 0.7978845608028654f * (x + 0.044715f * x * x * x); return x * __builtin_amdgcn_rcpf(1.f + __expf(-2.f * u)); }
__device__ __forceinline__ float log_sigmoid(float x) { return fminf(x, 0.f) - __logf(1.f + __expf(-fabsf(x))); }

struct P { const float* in[37]; float* out; unsigned char* ws; int layer; int pad; };
enum { I_X = 0, I_C, I_CTX, I_CCTX, I_N1G, I_N2G, I_ADAW, I_ADAB, I_WIN, I_BIN, I_MLCW, I_MLCB, I_MLNG, I_S5LR, I_S5LI, I_S5DT, I_S5BR, I_S5BI, I_S5CR, I_S5CI, I_S5D,
       I_GLUW, I_GLUB, I_DAQG, I_DAKG, I_LQ1, I_LK1, I_LQ2, I_LK2, I_SUBG, I_BRP, I_WOUT, I_RW, I_RB, I_EWG, I_EWU, I_EWD };

__device__ __forceinline__ void tr_item(const float* W, int ldw, int K, bf16* WT, int k0, int src_n0, int dst_n0, int nvalid, float* scr, int lane) {
    if (nvalid > 0) {
        f32x4 v[8]; const int ks = lane >> 3, n4 = (lane & 7) * 4;
#pragma unroll
        for (int i = 0; i < 8; ++i) v[i] = __builtin_nontemporal_load((const f32x4*)(W + (size_t)(k0 + 8 * i + ks) * ldw + src_n0 + n4));
#pragma unroll
        for (int i = 0; i < 8; ++i) { float* d = scr + (8 * i + ks) * 33 + n4; d[0] = v[i].x; d[1] = v[i].y; d[2] = v[i].z; d[3] = v[i].w; }
    }
    __builtin_amdgcn_s_waitcnt(0); asm volatile("" ::: "memory");
    const int c = lane & 7;
#pragma unroll
    for (int j = 0; j < 4; ++j) { const int n = (lane >> 3) + 8 * j; const float* s = scr + (8 * c) * 33 + n;
        u32x4 o = {0u, 0u, 0u, 0u};
        if (n < nvalid) { o.x = pk2(s[0 * 33], s[1 * 33]); o.y = pk2(s[2 * 33], s[3 * 33]); o.z = pk2(s[4 * 33], s[5 * 33]); o.w = pk2(s[6 * 33], s[7 * 33]); }
        __builtin_nontemporal_store(o, (u32x4*)(WT + (size_t)(dst_n0 + n) * K + k0 + 8 * c)); }
    __builtin_amdgcn_s_waitcnt(0); asm volatile("" ::: "memory");
}
constexpr int IT_IN = 32 * 448, IT_GLU = 16 * 32, IT_BR = 3 * 16 * 64, IT_OUT = 32 * 64, IT_G = 16 * 32 * 16, IT_U = IT_G, IT_DN = 16 * 8 * 64;
constexpr int IT_LAYER = IT_IN + IT_GLU + IT_BR + IT_OUT + IT_G + IT_U + IT_DN;
constexpr int IT_F0 = 6544, IT_F1 = IT_F0 + 27000, IT_F2 = IT_F1 + 10928;
static_assert(IT_F2 < IT_LAYER + 4096, "filler split");
constexpr int IT_FI = 3072;
constexpr int IT_SH = IT_FI + IT_F0 + IT_DN;
constexpr int IT_T = IT_FI + IT_F2;
constexpr int IT_P = DEPTH * IT_LAYER - (DEPTH - 1) * IT_T - IT_SH;
static_assert(IT_P >= IT_IN + IT_GLU && IT_P + IT_T >= IT_LAYER + IT_IN && IT_P + 2 * IT_T >= 2 * IT_LAYER + IT_IN && IT_P + 3 * IT_T >= 3 * IT_LAYER + IT_IN, "every layer's input-projection weights are converted before the layer starts");
static_assert(IT_FI + IT_F0 <= IT_G + IT_U, "the items of the input-projection and GLU tails must be gate / up weights (needed only by the later gate/up phase)");
__device__ __forceinline__ void prologue_transposes(const P& p, unsigned char* lds, int bid, int it0, int it1, int b0, int nb) { unsigned char* const ws = lp_(p.ws);
    if (bid < b0 || bid >= b0 + nb) return;
    const int tid = tid_(), wave = tid >> 6, lane = tid & 63;
    float* scr = (float*)(lds) + wave * (64 * 33);
    const int gw = (bid - b0) * 8 + wave, NGW = nb * 8;
    for (int it = it0 + gw; it < it1; it += NGW) {
        const int L = it / IT_LAYER; int r = it % IT_LAYER;
        if (r < IT_IN) { const int kb = r / 448, nb = r % 448; const int dn = nb * 32;
            int sn = dn < 4096 ? dn : dn + 16; const int nv = 32;
            if (dn >= C_DAQ && dn < C_DAV) { const int t0 = dn & 255;
                sn = (dn & ~255) + ((t0 & 127) >> 5) * 64 + (t0 >> 7) * 32 + 16; }
            tr_item(p.in[I_WIN] + (size_t)L * DM * IN_COLS, IN_COLS, DM, (bf16*)(ws + WS_WIN + L * SZ_WIN), kb * 64, sn, dn, nv, scr, lane); continue; }
        r -= IT_IN;
        if (r < IT_GLU) { const int kb = r / 32, nb = r % 32;
            tr_item(p.in[I_GLUW] + (size_t)L * MIXW * MIXW, MIXW, MIXW, (bf16*)(ws + WS_WGLU + L * SZ_WGLU), kb * 64, nb * 32, nb * 32, 32, scr, lane); continue; }
        r -= IT_GLU;
        if (r < IT_BR) { const int br = r / (16 * 64), q = r % (16 * 64), kb = q / 64, nb = q % 64;
            tr_item(p.in[I_BRP] + ((size_t)L * 3 + br) * MIXW * DM, DM, MIXW, (bf16*)(ws + WS_WBR + L * SZ_WBR) + (size_t)br * DM * MIXW, kb * 64, nb * 32, nb * 32, 32, scr, lane); continue; }
        r -= IT_BR;
        if (r < IT_OUT) { const int kb = r / 64, nb = r % 64;
            tr_item(p.in[I_WOUT] + (size_t)L * DM * DM, DM, DM, (bf16*)(ws + WS_WOUT + L * SZ_WOUT), kb * 64, nb * 32, nb * 32, 32, scr, lane); continue; }
        r -= IT_OUT;
        if (r < IT_G + IT_U) { const int up = r >= IT_G; if (up) r -= IT_G; const int e = r / (32 * 16), q = r % (32 * 16), kb = q / 16, nb = q % 16; const int sn = nb * 32;
            const int dn = (sn / 128) * 256 + (sn % 128) + (up ? 128 : 0);
            tr_item(p.in[up ? I_EWU : I_EWG] + ((size_t)L * NEXP + e) * DM * DFF, DFF, DM, (bf16*)(ws + WS_WGU + L * SZ_WGU) + (size_t)e * 2 * DFF * DM, kb * 64, sn, dn, 32, scr, lane); continue; }
        r -= IT_G + IT_U;
        { const int e = r / (8 * 64), q = r % (8 * 64), kb = q / 64, nb = q % 64;
            tr_item(p.in[I_EWD] + ((size_t)L * NEXP + e) * DFF * DM, DM, DFF, (bf16*)(ws + WS_WDN + L * SZ_WDN) + (size_t)e * DM * DFF, kb * 64, nb * 32, nb * 32, 32, scr, lane); }
    }
}
__device__ __forceinline__ void prologue_ada(const P& p, unsigned char* lds, int bid, int nblk) { unsigned char* const ws = lp_(p.ws);
    const int tid = tid_(), wave = tid >> 6, lane = tid & 63;
    float* sc = (float*)lds;
    float* red = (float*)lds + 5 * DM;
    constexpr int NU = DEPTH * 48;
    if (bid >= NU) return;
    for (int i = tid; i < 5 * DM; i += NT) { const int r = i / DM, k = i % DM; const float v = r < 4 ? p.in[I_C][r * DM + k] : p.in[I_CCTX][k]; sc[i] = siluf_(v); }
    __syncthreads();
    for (int u = bid; u < NU; u += nblk) {
        const int L = u / 48, cg = u % 48;
        const float* W = p.in[I_ADAW] + (size_t)L * DM * (6 * DM) + cg * 256 + 4 * lane;
        f32x4 a[5];
#pragma unroll
        for (int r = 0; r < 5; ++r) a[r] = (f32x4){0.f, 0.f, 0.f, 0.f};
        const int k0 = wave * 256;
#pragma unroll 8
        for (int k = 0; k < 256; ++k) { const f32x4 w = *(const f32x4*)(W + (size_t)(k0 + k) * (6 * DM));
#pragma unroll
            for (int r = 0; r < 5; ++r) a[r] += w * sc[r * DM + k0 + k]; }
#pragma unroll
        for (int r = 0; r < 5; ++r) *(f32x4*)(red + (wave * 5 + r) * 256 + 4 * lane) = a[r];
        __syncthreads();
        for (int i = tid; i < 5 * 256; i += NT) { const int r = i / 256, c = i % 256; float s = 0.f;
#pragma unroll
            for (int w = 0; w < 8; ++w) s += red[(w * 5 + r) * 256 + c];
            const int col = cg * 256 + c;
            ((float*)(ws + WS_MOD))[((size_t)L * 5 + r) * (6 * DM) + col] = s + p.in[I_ADAB][L * 6 * DM + col]; }
        __syncthreads();
    }
}
__device__ __forceinline__ void prologue_small(const P& p, int bid, int nblk) { unsigned char* const ws = lp_(p.ws);
    const int gt = bid * NT + tid_(), NG = nblk * NT;
    for (int i = gt; i < DEPTH * 2 * 64 * 64; i += NG) {
        const int L = i / 8192, q = i % 8192, dg = q / 64  , pp = q % 64;
        const float lre = p.in[I_S5LR][i], lim = p.in[I_S5LI][i];
        const float dt = expf(p.in[I_S5DT][L * 128 + dg]);
        const float x = lre * dt, th = lim * dt;
        const float em1 = expm1f(x), cs = cosf(th), sn = sinf(th), sh = sinf(0.5f * th);
        const float are = (em1 + 1.f) * cs, aim = (em1 + 1.f) * sn;
        const float nr = em1 * cs - 2.f * sh * sh, ni = aim;
        const float den = lre * lre + lim * lim;
        const float fr = (nr * lre + ni * lim) / den, fi = (ni * lre - nr * lim) / den;
        float* base = (float*)(ws + WS_S5P + L * S5P_STRIDE);
        base[q * 2] = are; base[q * 2 + 1] = aim;
        const float m16 = expf(16.f * x); base[16384 + q * 2] = m16 * cosf(16.f * th); base[16384 + q * 2 + 1] = m16 * sinf(16.f * th);
        float* bb = base + 32768 + (size_t)q * 32;
        const float* bre = p.in[I_S5BR] + (size_t)i * 16; const float* bim = p.in[I_S5BI] + (size_t)i * 16;
#pragma unroll
        for (int k = 0; k < 16; ++k) { bb[2 * k] = fr * bre[k] - fi * bim[k]; bb[2 * k + 1] = fr * bim[k] + fi * bre[k]; }
    }
    for (int i = gt; i < DEPTH * DM; i += NG) { const int L = i / DM, k = i % DM; const float* src = p.in[I_WIN] + ((size_t)L * DM + k) * IN_COLS + 4096;
        bf16* dst = (bf16*)(ws + WS_WG) + (size_t)L * 16 * DM + k;
#pragma unroll
        for (int q4 = 0; q4 < 4; ++q4) { const f32x4 w = *(const f32x4*)(src + 4 * q4);
            dst[(4 * q4 + 0) * DM] = (bf16)f2bf(w.x); dst[(4 * q4 + 1) * DM] = (bf16)f2bf(w.y); dst[(4 * q4 + 2) * DM] = (bf16)f2bf(w.z); dst[(4 * q4 + 3) * DM] = (bf16)f2bf(w.w); } }
    for (int i = gt; i < 64 * 16; i += NG) { const int pos = i / 16, f = i % 16; const float fq = powf(10000.f, -(float)f / 16.f); const float ang = (float)pos * fq;
        ((float*)(ws + WS_ROPE))[2 * i] = cosf(ang); ((float*)(ws + WS_ROPE))[2 * i + 1] = sinf(ang); }
}
__device__ __forceinline__ void phase_prologue(const P& p, unsigned char* lds, int bid, int nblk) {
    prologue_small(p, bid, nblk);
    prologue_ada(p, lds, bid, nblk);
    __syncthreads();
    if (PROBE_DUP == 11) { prologue_small(p, bid, nblk); prologue_ada(p, lds, bid, nblk); __syncthreads(); }
    prologue_transposes(p, lds, bid, 0, nblk == 256 ? IT_P : DEPTH * IT_LAYER, 0, nblk);
}

__device__ __forceinline__ int row_sel(int m) { const int b = m / NTOK, n = m % NTOK; return n < CTX ? 4 : b; }
__device__ __forceinline__ void load_z_row(const P& p, int L, int m, int lane, f32x4 (&v)[8]) {
    unsigned char* const ws = lp_(p.ws);
    const int b = m / NTOK, n = m % NTOK;
    if (L == 0) {
        const float* src = n < CTX ? p.in[I_CTX] + ((size_t)b * CTX + n) * DM : p.in[I_X] + ((size_t)b * SEQ + (n - CTX)) * DM;
#pragma unroll
        for (int j = 0; j < 8; ++j) v[j] = *(const f32x4*)(src + 4 * lane + 256 * j);
    } else {
        const bf16* z = (const bf16*)(ws + WS_Z) + (size_t)m * DM;
        const int* rt = (const int*)(ws + WS_ROUTE) + (size_t)m * 8;
        const float w0 = __int_as_float(rt[2]), w1 = __int_as_float(rt[3]); const int s0 = rt[4], s1 = rt[5];
        const bf16* y0 = (const bf16*)(ws + WS_RA) + (size_t)s0 * DM; const bf16* y1 = (const bf16*)(ws + WS_RA) + (size_t)s1 * DM;
        const float* md = (const float*)(ws + WS_MOD) + ((size_t)(L - 1) * 5 + row_sel(m)) * (6 * DM) + 5 * DM;
#pragma unroll
        for (int j = 0; j < 8; ++j) { const int c = 4 * lane + 256 * j; const u32x2 z2 = *(const u32x2*)(z + c); const f32x4 zz = {bflo(z2.x), bfhi(z2.x), bflo(z2.y), bfhi(z2.y)}; const f32x4 g = *(const f32x4*)(md + c);
            const u32x2 a = *(const u32x2*)(y0 + c), bq = *(const u32x2*)(y1 + c);
            f32x4 e; e.x = w0 * bflo(a.x) + w1 * bflo(bq.x); e.y = w0 * bfhi(a.x) + w1 * bfhi(bq.x); e.z = w0 * bflo(a.y) + w1 * bflo(bq.y); e.w = w0 * bfhi(a.y) + w1 * bfhi(bq.y);
            v[j] = zz + g * e; }
    }
}
template <bool DRY = false> __device__ __forceinline__ void phase_norm1(const P& p, int L, unsigned char* lds, int bid, int nblk) { unsigned char* const ws = lp_(p.ws);
    const int tid = tid_(), wave = tid >> 6, lane = tid & 63;
    const float* g1 = p.in[I_N1G] + L * DM;
    unsigned short* wg = (unsigned short*)lds;
    { const u32x4* wsrc = (const u32x4*)(ws + WS_WG + (size_t)L * 16 * DM * 2);
#pragma unroll
      for (int i = 0; i < 8; ++i) ((u32x4*)wg)[tid + NT * i] = wsrc[tid + NT * i];
      __syncthreads(); }
    const float gbias = p.in[I_BIN][(size_t)L * IN_COLS + 4096 + (((lane >> 5) & 1) * 8 + ((lane >> 4) & 1) * 4 + ((lane >> 3) & 1) * 2 + ((lane >> 2) & 1))];
    const int rpb = (MROWS + nblk - 1) / nblk;
    int crs = -1; f32x4 cA[8]; const float* mdB = nullptr;
    for (int m = bid * rpb + wave; m < min(MROWS, (bid + 1) * rpb); m += 8) {
        const int rs = __builtin_amdgcn_readfirstlane(row_sel(m));
        if (rs != crs) { crs = rs; const float* md = (const float*)(ws + WS_MOD) + ((size_t)L * 5 + rs) * (6 * DM);
#pragma unroll
            for (int j = 0; j < 8; ++j) { const int c = 4 * lane + 256 * j; cA[j] = *(const f32x4*)(g1 + c) * (*(const f32x4*)(md + DM + c) + 1.f); } mdB = md; }
        f32x4 v[8]; load_z_row(p, L, m, lane, v);
        bf16* z = (bf16*)(ws + (DRY ? WS_RA + RA_HML : WS_Z)) + (size_t)m * DM;
        float ss = 0.f;
#pragma unroll
        for (int j = 0; j < 8; ++j) { u32x2 zw; zw.x = pk2(v[j].x, v[j].y); zw.y = pk2(v[j].z, v[j].w); *(u32x2*)(z + 4 * lane + 256 * j) = zw; ss += v[j].x * v[j].x + v[j].y * v[j].y + v[j].z * v[j].z + v[j].w * v[j].w; }
        const float rstd = rsqrtf(wave_sum(ss) * (1.f / DM) + EPS);
        bf16* h = (bf16*)(ws + (DRY ? WS_RA + RA_QK : WS_H)) + (size_t)m * DM;
#pragma unroll
        for (int j = 0; j < 8; ++j) { const int c = 4 * lane + 256 * j;
            const f32x4 o = v[j] * rstd * cA[j] + *(const f32x4*)(mdB + c); u32x2 w; w.x = pk2(o.x, o.y); w.y = pk2(o.z, o.w); *(u32x2*)(h + c) = w; v[j] = o; }
        float ga[16];
#pragma unroll
        for (int q = 0; q < 16; ++q) { float a = 0.f;
#pragma unroll
            for (int j = 0; j < 8; ++j) { const u32x2 ww = *(const u32x2*)(wg + q * DM + 4 * lane + 256 * j); a += v[j].x * bflo(ww.x) + v[j].y * bfhi(ww.x) + v[j].z * bflo(ww.y) + v[j].w * bfhi(ww.y); }
            ga[q] = a; }
        { const bool h5 = lane & 32, h4 = lane & 16, h3 = lane & 8, h2 = lane & 4; float r8[8], r4[4], r2[2], r1;
#pragma unroll
          for (int i = 0; i < 8; ++i) { const float keep = h5 ? ga[i + 8] : ga[i], send = h5 ? ga[i] : ga[i + 8]; r8[i] = keep + xor32(send, h5); }
#pragma unroll
          for (int i = 0; i < 4; ++i) { const float keep = h4 ? r8[i + 4] : r8[i], send = h4 ? r8[i] : r8[i + 4]; r4[i] = keep + xorl<16>(send); }
#pragma unroll
          for (int i = 0; i < 2; ++i) { const float keep = h3 ? r4[i + 2] : r4[i], send = h3 ? r4[i] : r4[i + 2]; r2[i] = keep + xorl<8>(send); }
          { const float keep = h2 ? r2[1] : r2[0], send = h2 ? r2[0] : r2[1]; r1 = keep + xorl<4>(send); }
          r1 += xorl<2>(r1); r1 += xorl<1>(r1);
          if ((lane & 3) == 0) ((float*)(ws + (DRY ? WS_S5E : WS_GATES)))[(size_t)m * 16 + (lane >> 2)] = r1 + gbias; }
    }
}
__device__ __forceinline__ void phase_final(const P& p, int bid, int nblk) { unsigned char* const ws = lp_(p.ws);
    const int tid = tid_(), wave = tid >> 6, lane = tid & 63;
    for (int r = bid * 8 + wave; r < NB * SEQ; r += nblk * 8) {
        const int b = r / SEQ, l = r % SEQ, m = b * NTOK + CTX + l;
        f32x4 v[8]; load_z_row(p, DEPTH, m, lane, v);
        float* o = p.out + (size_t)r * DM;
#pragma unroll
        for (int j = 0; j < 8; ++j) *(f32x4*)(o + 4 * lane + 256 * j) = v[j];
    }
}

namespace pg8 {
struct EpiInproj {
    static constexpr bool PERM = true, AFTER_DRAIN = false, KEEP = false;
    bf16_t* O; const float* bias; bf16_t* A2; bf16_t* QN; bf16_t* KN; const float* qg; const float* kg; const float* rope; bf16_t* QKo; const float* cw; const float* cb;
    __device__ __forceinline__ void qk_tile(const f32x4 (&acc)[2][2][4][2], const Unit& u, int wr, int wc, int fr, int fq) const {
        const bool isk = u.pn >= C_DAK / BM; const int grp = (u.pn - (isk ? C_DAK : C_DAQ) / BM) * 4 + wc;
        const int row0 = u.pm * BM + wr * 64 + fr; const bool lat = (u.pm % 9) != 0; const int nb0 = (u.pm % 9) * BM - CTX + wr * 64 + fr;
        const float* gsrc = isk ? kg : qg; bf16_t* dst = isk ? KN : QN;
        const int ocol = u.pn * BM + wc * 64 + 8 * fq + 16;
        f32x4 bv[2][2], gv[2][2];
#pragma unroll
        for (int bj = 0; bj < 2; ++bj)
#pragma unroll
            for (int n = 0; n < 2; ++n) { bv[bj][n] = *(const f32x4*)(bias + ocol + bj * 32 + 4 * n); gv[bj][n] = *(const f32x4*)(gsrc + bj * 32 + 8 * fq + 4 * n) * (isk ? 1.f : 0.18033688011112042f); }
        const bool x2 = fq >= 2; const int fi = 8 * (fq & 1);
#pragma unroll
        for (int ai = 0; ai < 2; ++ai)
#pragma unroll
            for (int m = 0; m < 4; ++m) { f32x4 v[2][2]; float ss = 0.f;
#pragma unroll
                for (int bj = 0; bj < 2; ++bj)
#pragma unroll
                    for (int n = 0; n < 2; ++n) { v[bj][n] = acc[ai][bj][m][n] + bv[bj][n]; ss += v[bj][n][0] * v[bj][n][0] + v[bj][n][1] * v[bj][n][1] + v[bj][n][2] * v[bj][n][2] + v[bj][n][3] * v[bj][n][3]; }
                ss += xorl<16>(ss); { const auto rr = __builtin_amdgcn_permlane32_swap(__float_as_uint(ss), __float_as_uint(ss), false, false); ss = __uint_as_float(rr[0]) + __uint_as_float(rr[1]); }
                const float rstd = rsqrtf(ss * (1.f / 64.f) + EPS);
                const int l = nb0 + ai * HALF + m * 16;
#pragma unroll
                for (int bj = 0; bj < 2; ++bj) { const int pos = bj == 0 ? (l >> 6) : (l & 63);
                    u32x4 w;
#pragma unroll
                    for (int n = 0; n < 2; ++n) { f32x4 x = v[bj][n] * rstd * gv[bj][n];
                        if (lat) { const f32x4 c01 = *(const f32x4*)(rope + (pos * 16 + fi + 4 * n) * 2), c23 = *(const f32x4*)(rope + (pos * 16 + fi + 4 * n + 2) * 2);
                            const float cs[4] = {c01[0], c01[2], c23[0], c23[2]}, sn[4] = {c01[1], c01[3], c23[1], c23[3]};
#pragma unroll
                            for (int k = 0; k < 4; ++k) { const float other = xor32(x[k], x2); x[k] = x2 ? (other * sn[k] + x[k] * cs[k]) : (x[k] * cs[k] - other * sn[k]); } }
                        if (n == 0) { w.x = cvt_pk_bf16(x[0], x[1]); w.y = cvt_pk_bf16(x[2], x[3]); } else { w.z = cvt_pk_bf16(x[0], x[1]); w.w = cvt_pk_bf16(x[2], x[3]); } }
                    *(u32x4*)(dst + (size_t)(row0 + ai * HALF + m * 16) * 1024 + grp * 64 + bj * 32 + 8 * fq) = w; } }
    }
    __device__ __forceinline__ void ml_tile(const f32x4 (&acc)[2][2][4][2], const Unit& u, int wr, int wc, int fr, int fq) const {
        const int row0 = u.pm * BM + wr * 64 + fr, col0 = u.pn * BM + wc * 32 + 8 * fq; const float ksc = u.pn >= C_MLK / BM ? 0.0625f : 1.f;
        const bool halo = fr < 2 || fr > 13, inner = fr >= 1 && fr <= 14;
#pragma unroll
        for (int bj = 0; bj < 2; ++bj) { const int c = col0 + bj * HALF;
            f32x4 bb[2], w0[2], w1[2], w2[2], cbv[2];
#pragma unroll
            for (int n = 0; n < 2; ++n) { bb[n] = *(const f32x4*)(bias + c + 4 * n); w0[n] = *(const f32x4*)(cw + c + 4 * n); w1[n] = *(const f32x4*)(cw + 2048 + c + 4 * n); w2[n] = *(const f32x4*)(cw + 4096 + c + 4 * n); cbv[n] = *(const f32x4*)(cb + c + 4 * n); }
#pragma unroll
            for (int ai = 0; ai < 2; ++ai)
#pragma unroll
                for (int m = 0; m < 4; ++m) { const size_t row = (size_t)(row0 + ai * HALF + m * 16); u32x4 wr_, wo;
#pragma unroll
                    for (int n = 0; n < 2; ++n) { const f32x4 x = acc[ai][bj][m][n] + bb[n]; f32x4 o;
#pragma unroll
                        for (int k = 0; k < 4; ++k) { const float xp = dppf<0x111>(x[k], x[k]), xn = dppf<0x101>(x[k], x[k]);
                            o[k] = siluf_(cbv[n][k] + w0[n][k] * xp + w1[n][k] * x[k] + w2[n][k] * xn) * ksc; }
                        if (n == 0) { wr_.x = cvt_pk_bf16(x[0], x[1]); wr_.y = cvt_pk_bf16(x[2], x[3]); wo.x = cvt_pk_bf16(o[0], o[1]); wo.y = cvt_pk_bf16(o[2], o[3]); }
                        else { wr_.z = cvt_pk_bf16(x[0], x[1]); wr_.w = cvt_pk_bf16(x[2], x[3]); wo.z = cvt_pk_bf16(o[0], o[1]); wo.w = cvt_pk_bf16(o[2], o[3]); } }
                    if (halo) *(u32x4*)(O + row * NPROJ + c) = wr_;
                    if (inner) *(u32x4*)(QKo + row * 2048 + c) = wo; } }
    }
    __device__ __forceinline__ void operator()(const f32x4 (&acc)[2][2][4][2], const Unit& u, int wr, int wc, int fr, int fq) const {
        if (u.pn >= C_DAQ / BM && u.pn < C_DAV / BM) { qk_tile(acc, u, wr, wc, fr, fq); return; }
        if (u.pn < C_MLV / BM) { ml_tile(acc, u, wr, wc, fr, fq); return; }
        const int row0 = u.pm * BM + wr * 64 + fr;
        const int col0 = u.pn * BM + wc * 32 + 8 * fq, bcol0 = col0 < 4096 ? col0 : col0 + 16;
        const bool s5t = (u.pn >= C_S5U / BM) && (u.pn < C_DAQ / BM); const int s5b = (u.pm * BM) / NTOK, s5row = s5b * 144 + ((u.pm * BM - s5b * NTOK + wr * 64) >> 4);
        f32x4 bv[2][2];
#pragma unroll
        for (int bj = 0; bj < 2; ++bj)
#pragma unroll
            for (int n = 0; n < 2; ++n) bv[bj][n] = *(const f32x4*)(bias + bcol0 + bj * HALF + 4 * n);
#pragma unroll
        for (int ai = 0; ai < 2; ++ai)
#pragma unroll
            for (int m = 0; m < 4; ++m) { bf16_t* rowp = O + (size_t)(row0 + ai * HALF + m * 16) * NPROJ + col0;
#pragma unroll
                for (int bj = 0; bj < 2; ++bj) { const f32x4 v0 = acc[ai][bj][m][0] + bv[bj][0], v1 = acc[ai][bj][m][1] + bv[bj][1];
                    u32x4 w; w.x = cvt_pk_bf16(v0[0], v0[1]); w.y = cvt_pk_bf16(v0[2], v0[3]); w.z = cvt_pk_bf16(v1[0], v1[1]); w.w = cvt_pk_bf16(v1[2], v1[3]);
                    if (s5t) { const int ch = col0 + bj * HALF - C_S5U;
                        *(u32x4*)(A2 + ((size_t)(ch >> 4) * S5ROWS + s5row + ai * 8 + m) * 512 + 256 + (fr & 15) * 16 + (ch & 15)) = w; }
                    else *(u32x4*)(rowp + bj * HALF) = w; } }
    }
};
struct EpiGlu {
    static constexpr bool PERM = true, AFTER_DRAIN = false, KEEP = false;
    const bf16_t* Z5; bf16_t* O; const float* bias;
    __device__ __forceinline__ void operator()(const f32x4 (&acc)[2][2][4][2], const Unit& u, int wr, int wc, int fr, int fq) const {
        const int row0 = u.pm * BM + wr * 64 + fr, col0 = u.pn * BM + wc * 32 + 8 * fq;
#pragma unroll
        for (int ai = 0; ai < 2; ++ai)
#pragma unroll
            for (int m = 0; m < 4; ++m) { const size_t off = (size_t)(row0 + ai * HALF + m * 16) * MIXW + col0;
#pragma unroll
                for (int bj = 0; bj < 2; ++bj) { const u32x4 zz = *(const u32x4*)(Z5 + off + bj * HALF);
                    const f32x4 b0 = *(const f32x4*)(bias + col0 + bj * HALF), b1 = *(const f32x4*)(bias + col0 + bj * HALF + 4);
                    const f32x4 v0 = acc[ai][bj][m][0] + b0, v1 = acc[ai][bj][m][1] + b1;
                    u32x4 w;
                    w.x = cvt_pk_bf16(bflo(zz.x) * sigmoidf_(v0[0]), bfhi(zz.x) * sigmoidf_(v0[1])); w.y = cvt_pk_bf16(bflo(zz.y) * sigmoidf_(v0[2]), bfhi(zz.y) * sigmoidf_(v0[3]));
                    w.z = cvt_pk_bf16(bflo(zz.z) * sigmoidf_(v1[0]), bfhi(zz.z) * sigmoidf_(v1[1])); w.w = cvt_pk_bf16(bflo(zz.w) * sigmoidf_(v1[2]), bfhi(zz.w) * sigmoidf_(v1[3]));
                    *(u32x4*)(O + off + bj * HALF) = w; } }
    }
};
struct EpiBranch {
    static constexpr bool PERM = true, AFTER_DRAIN = false, KEEP = true;
    const bf16_t* GB; bf16_t* MGB;
    __device__ __forceinline__ float em(float x) const { return __expf(-fminf(fmaxf(x, -30.f), 30.f)); }
    __device__ __forceinline__ void operator()(f32x4 (&acc)[2][2][4][2], const Unit& u, int wr, int wc, int fr, int fq) const {
        const int row0 = u.pm * BM + wr * 64 + fr, col0 = u.pn * BM + wc * 32 + 8 * fq; const int r = u.pr;
#pragma unroll
        for (int ai = 0; ai < 2; ++ai)
#pragma unroll
            for (int m = 0; m < 4; ++m) { const size_t row = (size_t)(row0 + ai * HALF + m * 16);
#pragma unroll
                for (int bj = 0; bj < 2; ++bj) { const int c = col0 + bj * HALF; const u32x4 ga = *(const u32x4*)(GB + row * NPROJ + r * DM + c);
                    float sc[8];
                    if (r < 2) { const u32x4 gn = *(const u32x4*)(GB + row * NPROJ + (r + 1) * DM + c);
#pragma unroll
                        for (int k = 0; k < 4; ++k) { sc[2 * k] = (1.f + em(bflo(gn[k]))) * __builtin_amdgcn_rcpf(1.f + em(bflo(ga[k]))); sc[2 * k + 1] = (1.f + em(bfhi(gn[k]))) * __builtin_amdgcn_rcpf(1.f + em(bfhi(ga[k]))); }
                    } else {
#pragma unroll
                        for (int k = 0; k < 4; ++k) { sc[2 * k] = __builtin_amdgcn_rcpf(1.f + em(bflo(ga[k]))); sc[2 * k + 1] = __builtin_amdgcn_rcpf(1.f + em(bfhi(ga[k]))); } }
                    f32x4 v0 = acc[ai][bj][m][0], v1 = acc[ai][bj][m][1];
                    v0[0] *= sc[0]; v0[1] *= sc[1]; v0[2] *= sc[2]; v0[3] *= sc[3]; v1[0] *= sc[4]; v1[1] *= sc[5]; v1[2] *= sc[6]; v1[3] *= sc[7];
                    acc[ai][bj][m][0] = v0; acc[ai][bj][m][1] = v1;
                    if (r == 2) { u32x4 w; w.x = cvt_pk_bf16(v0[0], v0[1]); w.y = cvt_pk_bf16(v0[2], v0[3]); w.z = cvt_pk_bf16(v1[0], v1[1]); w.w = cvt_pk_bf16(v1[2], v1[3]); *(u32x4*)(MGB + row * DM + c) = w; } } }
    }
};
struct BranchOrder {
    StaticOrder T;
    __device__ __forceinline__ bool next(int i, Unit& u) const { if (!T.next(i / 3, u)) return false; const int r = i % 3; u.pr = r; u.pa = r * (MROWS / BM) + u.pm; u.pb = r * (DM / BM) + u.pn; return true; }
    __device__ __forceinline__ void a_ready(const Unit&) const {}
    __device__ __forceinline__ void done(const Unit&) const {}
};
struct EpiOut {
    static constexpr bool PERM = true, AFTER_DRAIN = false, KEEP = false;
    bf16_t* Z; const float* MODL;
    __device__ __forceinline__ void operator()(const f32x4 (&acc)[2][2][4][2], const Unit& u, int wr, int wc, int fr, int fq) const {
        const int row0 = u.pm * BM + wr * 64 + fr, col0 = u.pn * BM + wc * 32 + 8 * fq;
        const int rs = row_sel(u.pm * BM);
        const float* g2 = MODL + (size_t)rs * (6 * DM) + 2 * DM;
#pragma unroll
        for (int ai = 0; ai < 2; ++ai)
#pragma unroll
            for (int m = 0; m < 4; ++m) { bf16_t* zr = Z + (size_t)(row0 + ai * HALF + m * 16) * DM;
#pragma unroll
                for (int bj = 0; bj < 2; ++bj) { const int c = col0 + bj * HALF;
                    const f32x4 ga = *(const f32x4*)(g2 + c), gb = *(const f32x4*)(g2 + c + 4); const u32x4 zo = *(const u32x4*)(zr + c);
                    const f32x4 v0 = (f32x4){bflo(zo.x), bfhi(zo.x), bflo(zo.y), bfhi(zo.y)} + ga * acc[ai][bj][m][0], v1 = (f32x4){bflo(zo.z), bfhi(zo.z), bflo(zo.w), bfhi(zo.w)} + gb * acc[ai][bj][m][1];
                    u32x4 w; w.x = cvt_pk_bf16(v0[0], v0[1]); w.y = cvt_pk_bf16(v0[2], v0[3]); w.z = cvt_pk_bf16(v1[0], v1[1]); w.w = cvt_pk_bf16(v1[2], v1[3]); *(u32x4*)(zr + c) = w; } }
    }
};
struct EpiGateUp {
    static constexpr bool PERM = true, AFTER_DRAIN = false, KEEP = false;
    bf16_t* ACT;
    __device__ __forceinline__ void operator()(const f32x4 (&acc)[2][2][4][2], const Unit& u, int wr, int wc, int fr, int fq) const {
        const int row0 = u.pm * BM + wr * 64 + fr, f0 = u.pn * HALF + wc * 32 + 8 * fq;
#pragma unroll
        for (int ai = 0; ai < 2; ++ai)
#pragma unroll
            for (int m = 0; m < 4; ++m) { const f32x4 g0 = acc[ai][0][m][0], g1 = acc[ai][0][m][1], u0 = acc[ai][1][m][0], u1 = acc[ai][1][m][1];
                u32x4 w; w.x = cvt_pk_bf16(siluf_(g0[0]) * u0[0], siluf_(g0[1]) * u0[1]); w.y = cvt_pk_bf16(siluf_(g0[2]) * u0[2], siluf_(g0[3]) * u0[3]);
                w.z = cvt_pk_bf16(siluf_(g1[0]) * u1[0], siluf_(g1[1]) * u1[1]); w.w = cvt_pk_bf16(siluf_(g1[2]) * u1[2], siluf_(g1[3]) * u1[3]);
                *(u32x4*)(ACT + (size_t)(row0 + ai * HALF + m * 16) * DFF + f0) = w; }
    }
};
struct EpiPlainBf16 {
    static constexpr bool PERM = true, AFTER_DRAIN = false, KEEP = false;
    bf16_t* O; int ldc;
    __device__ __forceinline__ void operator()(const f32x4 (&acc)[2][2][4][2], const Unit& u, int wr, int wc, int fr, int fq) const {
        const int row0 = u.pm * BM + wr * 64 + fr, col0 = u.pn * BM + wc * 32 + 8 * fq;
#pragma unroll
        for (int ai = 0; ai < 2; ++ai)
#pragma unroll
            for (int m = 0; m < 4; ++m) { bf16_t* rowp = O + (size_t)(row0 + ai * HALF + m * 16) * ldc + col0;
#pragma unroll
                for (int bj = 0; bj < 2; ++bj) { const f32x4 v0 = acc[ai][bj][m][0], v1 = acc[ai][bj][m][1];
                    u32x4 w; w.x = cvt_pk_bf16(v0[0], v0[1]); w.y = cvt_pk_bf16(v0[2], v0[3]); w.z = cvt_pk_bf16(v1[0], v1[1]); w.w = cvt_pk_bf16(v1[2], v1[3]);
                    *(u32x4*)(rowp + bj * HALF) = w; } }
    }
};
struct MoeOrder {
    const int* pre;
    int ncol, G, c;
    __device__ __forceinline__ bool next(int i, Unit& u) const {
        const int L = i * G + c; const int tot = pre[16];
        if (L >= tot * ncol) return false;
        const int tg = L / ncol, pn = L % ncol; int e = 0;
#pragma unroll
        for (int k = 1; k < 16; ++k) e += (tg >= pre[k]) ? 1 : 0;
        u.pm = e * (ECAP / BM) + (tg - pre[e]); u.pn = pn; u.pb = e * ncol + pn; u.pa = u.pm; u.pr = 0; return true;
    }
    __device__ __forceinline__ void a_ready(const Unit&) const {}
    __device__ __forceinline__ void done(const Unit&) const {}
};
}

__device__ __forceinline__ int tok_of(int pp, int dir) { return dir == 0 ? pp : (pp < CTX ? CTX - 1 - pp : NTOK + CTX - 1 - pp); }
__device__ __forceinline__ void phase_mlconv(const P& p, int L, int bid, int nblk) { unsigned char* const ws = lp_(p.ws);
    const int tid = tid_(), wave = tid >> 6, lane = tid & 63;
    const bf16* PROJ = (const bf16*)(ws + WS_RA + RA_PROJ); bf16* QK = (bf16*)(ws + WS_RA + RA_QK);
    const float* cw = p.in[I_MLCW] + (size_t)L * 3 * 2048; const float* cb = p.in[I_MLCB] + L * 2048;
    for (int i = bid * 8 + wave; i < MROWS / 8; i += nblk * 8) {
        const int m = (i >> 1) * 16 + ((i & 1) ? 15 : 0);
        const int n = m % NTOK; const bool hp = !(n == 0 || n == CTX), hn = !(n == CTX - 1 || n == NTOK - 1);
#pragma unroll
        for (int j = 0; j < 4; ++j) { const int c = 8 * lane + 512 * j;
            const u32x4 xc = *(const u32x4*)(PROJ + (size_t)m * NPROJ + c);
            u32x4 xp = {0u, 0u, 0u, 0u}, xn = {0u, 0u, 0u, 0u};
            if (hp) xp = *(const u32x4*)(PROJ + (size_t)(m - 1) * NPROJ + c);
            if (hn) xn = *(const u32x4*)(PROJ + (size_t)(m + 1) * NPROJ + c);
            float o[8];
#pragma unroll
            for (int k = 0; k < 8; ++k) { const unsigned wp = xp[k >> 1], wc = xc[k >> 1], wn = xn[k >> 1];
                const float vp = (k & 1) ? bfhi(wp) : bflo(wp), vc = (k & 1) ? bfhi(wc) : bflo(wc), vn = (k & 1) ? bfhi(wn) : bflo(wn);
                const float y = cb[c + k] + cw[c + k] * vp + cw[2048 + c + k] * vc + cw[4096 + c + k] * vn;
                o[k] = siluf_(y) * (c >= 1024 ? 0.0625f : 1.f); }
            u32x4 w; w.x = pk2(o[0], o[1]); w.y = pk2(o[2], o[3]); w.z = pk2(o[4], o[5]); w.w = pk2(o[6], o[7]);
            *(u32x4*)(QK + (size_t)m * 2048 + c) = w; }
    }
}
__device__ __forceinline__ void phase_qkprep(const P& p, int L, int bid, int nblk) { unsigned char* const ws = lp_(p.ws);
    const int tid = tid_(), wave = tid >> 6, lane = tid & 63;
    const bf16* PROJ = (const bf16*)(ws + WS_RA + RA_PROJ);
    const float* rope = (const float*)(ws + WS_ROPE);
    const int grp = lane >> 2, l4 = lane & 3;
    for (int m = bid * 8 + wave; m < MROWS; m += nblk * 8) {
        const int n = m % NTOK; const bool lat = n >= CTX; const int l = n - CTX; const int pos = (l4 < 2) ? (l >> 6) : (l & 63);
#pragma unroll
        for (int qk = 0; qk < 2; ++qk) {
            const bf16* src = PROJ + (size_t)m * NPROJ + (qk ? C_DAK : C_DAQ) + grp * 64 + l4 * 16;
            const float* g = p.in[qk ? I_DAKG : I_DAQG] + L * 64 + l4 * 16;
            bf16* dst = (bf16*)(ws + WS_RA + (qk ? RA_KN : RA_QN)) + (size_t)m * 1024 + grp * 64 + l4 * 16;
            const u32x4 a = *(const u32x4*)src, b = *(const u32x4*)(src + 8);
            float v[16];
#pragma unroll
            for (int k = 0; k < 4; ++k) { v[2 * k] = bflo(a[k]); v[2 * k + 1] = bfhi(a[k]); v[8 + 2 * k] = bflo(b[k]); v[8 + 2 * k + 1] = bfhi(b[k]); }
            float ss = 0.f;
#pragma unroll
            for (int k = 0; k < 16; ++k) ss += v[k] * v[k];
            ss += xorl<1>(ss); ss += xorl<2>(ss);
            const float rstd = rsqrtf(ss * (1.f / 64.f) + EPS);
#pragma unroll
            for (int k = 0; k < 16; ++k) v[k] = v[k] * rstd * g[k];
            float o[16];
#pragma unroll
            for (int k = 0; k < 16; ++k) { const float other = xorl<1>(v[k]);
                float r = v[k];
                if (lat) { const float cs = rope[(pos * 16 + k) * 2], sn = rope[(pos * 16 + k) * 2 + 1];
                    r = (l4 & 1) ? (other * sn + v[k] * cs) : (v[k] * cs - other * sn); }
                o[k] = r; }
            u32x4 w0, w1; w0.x = pk2(o[0], o[1]); w0.y = pk2(o[2], o[3]); w0.z = pk2(o[4], o[5]); w0.w = pk2(o[6], o[7]);
            w1.x = pk2(o[8], o[9]); w1.y = pk2(o[10], o[11]); w1.z = pk2(o[12], o[13]); w1.w = pk2(o[14], o[15]);
            *(u32x4*)dst = w0; *(u32x4*)(dst + 8) = w1;
        }
    }
}

namespace pg8 {
struct S5Order {
    int G, c;
    __device__ __forceinline__ bool next(int i, Unit& u) const { const int L = i * G + c; if (L >= 192) return false; u.pm = L; u.pn = 0; u.pb = L / 3; u.pa = L; u.pr = 0; return true; }
    __device__ __forceinline__ void a_ready(const Unit&) const {}
    __device__ __forceinline__ void done(const Unit&) const {}
};
struct EpiS5E {
    static constexpr bool PERM = true, AFTER_DRAIN = false, KEEP = false;
    float* E;
    __device__ __forceinline__ void operator()(const f32x4 (&acc)[2][2][4][2], const Unit& u, int wr, int wc, int fr, int fq) const {
        const int row0 = u.pm * BM + wr * 64 + fr, col0 = wc * 32 + 8 * fq;
#pragma unroll
        for (int ai = 0; ai < 2; ++ai)
#pragma unroll
            for (int m = 0; m < 4; ++m) { float* rp = E + (size_t)(row0 + ai * HALF + m * 16) * 256 + col0;
#pragma unroll
                for (int bj = 0; bj < 2; ++bj) { *(f32x4*)(rp + bj * HALF) = acc[ai][bj][m][0]; *(f32x4*)(rp + bj * HALF + 4) = acc[ai][bj][m][1]; } }
    }
};
struct EpiS5Y {
    static constexpr bool PERM = true, AFTER_DRAIN = false, KEEP = false;
    bf16_t* Z5;
    __device__ __forceinline__ void operator()(const f32x4 (&acc)[2][2][4][2], const Unit& u, int wr, int wc, int fr, int fq) const {
        const int g = u.pm / 3, rbase = (u.pm % 3) * BM + wr * 64 + fr, col0 = wc * 32 + 8 * fq;
#pragma unroll
        for (int ai = 0; ai < 2; ++ai)
#pragma unroll
            for (int m = 0; m < 4; ++m) { const int rr = rbase + ai * HALF + m * 16;
                if (rr < 576) { const int b = rr / 144, kb = rr % 144;
#pragma unroll
                    for (int bj = 0; bj < 2; ++bj) { const int c = col0 + bj * HALF, tau = c >> 4, i0 = c & 15; const f32x4 v0 = acc[ai][bj][m][0], v1 = acc[ai][bj][m][1];
                        u32x4 w; w.x = cvt_pk_bf16(gelu_tanh(v0[0]), gelu_tanh(v0[1])); w.y = cvt_pk_bf16(gelu_tanh(v0[2]), gelu_tanh(v0[3]));
                        w.z = cvt_pk_bf16(gelu_tanh(v1[0]), gelu_tanh(v1[1])); w.w = cvt_pk_bf16(gelu_tanh(v1[2]), gelu_tanh(v1[3]));
                        *(u32x4*)(Z5 + ((size_t)b * NTOK + 16 * kb + tau) * MIXW + g * 16 + i0) = w; } } }
    }
};
}
__device__ __forceinline__ void phase_s5_gemm1(const P& p, int L, LAS unsigned char* lds, int bid, int nblk) { unsigned char* const ws = lp_(p.ws);
    pg8::Gemm g{(const bf16*)(ws + WS_RA + RA_S5A) + 256, (const bf16*)(ws + WS_S5T1 + L * SZ_S5T1), 64 * S5ROWS, 256, 256, 512}; pg8::S5Order S{nblk, bid};
    pg8::EpiS5E E{(float*)(ws + WS_RA + RA_S5E)};
    pg8::gemm_phase<pg8::EpiS5E, pg8::S5Order, true, true>(lds, g, S, E); }
__device__ __forceinline__ void phase_s5_gemm2(const P& p, int L, LAS unsigned char* lds, int bid, int nblk) { unsigned char* const ws = lp_(p.ws);
    pg8::Gemm g{(const bf16*)(ws + WS_RA + RA_S5A), (const bf16*)(ws + WS_S5T2 + L * SZ_S5T2), 64 * S5ROWS, 256, 512, 512}; pg8::S5Order S{nblk, bid};
    pg8::EpiS5Y E{(bf16*)(ws + WS_RA + RA_Z5)};
    pg8::gemm_phase<pg8::EpiS5Y, pg8::S5Order, true, true>(lds, g, S, E); }
__device__ __forceinline__ void phase_s5_scan(const P& p, int L, int bid, int nblk) { unsigned char* const ws = lp_(p.ws);
    const int tid = tid_(), wave = tid >> 6, lane = tid & 63;
    const float* S5 = (const float*)(ws + WS_S5P + L * S5P_STRIDE);
    const float* E = (const float*)(ws + WS_RA + RA_S5E); bf16* A2 = (bf16*)(ws + WS_RA + RA_S5A);
    const int sb = nblk == 256 ? bid - 192 : bid, sn = nblk == 256 ? 64 : nblk;
    if (sb < 0) return;
    for (int seq = sb * 8 + wave; seq < 512; seq += sn * 8) {
        const int dir = seq & 1, b = (seq >> 1) & 3, g = seq >> 3; const int q = dir * 4096 + g * 64 + lane;
        const float are = S5[16384 + q * 2], aim = S5[16384 + q * 2 + 1];
        float s_re = 0.f, s_im = 0.f;
        const size_t rbase = (size_t)g * S5ROWS + b * 144;
        const float* Eb = E + rbase * 256 + dir * 128 + lane; bf16* Ab = A2 + rbase * 512 + dir * 128 + lane;
#define S5_KB(k) (dir == 0 ? (k) : ((k) < 16 ? 15 - (k) : 159 - (k)))
        float cr[16], ci[16], nr_[16], ni_[16];
#pragma unroll
        for (int t = 0; t < 16; ++t) { const int kb = S5_KB(t); cr[t] = Eb[(size_t)kb * 256]; ci[t] = Eb[(size_t)kb * 256 + 64]; }
#pragma unroll 1
        for (int g = 0; g < 9; ++g) {
            const int gn = g + 1 < 9 ? g + 1 : g;
#pragma unroll
            for (int t = 0; t < 16; ++t) { const int kb = S5_KB(gn * 16 + t); nr_[t] = Eb[(size_t)kb * 256]; ni_[t] = Eb[(size_t)kb * 256 + 64]; }
#pragma unroll
            for (int t = 0; t < 16; ++t) { const int kb = S5_KB(g * 16 + t);
                Ab[(size_t)kb * 512] = (bf16)f2bf(s_re); Ab[(size_t)kb * 512 + 64] = (bf16)f2bf(s_im);
                const float nr = are * s_re - aim * s_im + cr[t], ni = are * s_im + aim * s_re + ci[t]; s_re = nr; s_im = ni; }
#pragma unroll
            for (int t = 0; t < 16; ++t) { cr[t] = nr_[t]; ci[t] = ni_[t]; } }
#undef S5_KB
    }
}
__device__ __forceinline__ void prologue_s5tables(const P& p, unsigned char* lds, int bid, int nblk) { unsigned char* const ws = lp_(p.ws);
    const int tid = tid_();
    float* ap = (float*)lds;
    float* bb = ap + 2 * 17 * 64 * 2;
    float* cc = bb + 2 * 64 * 16 * 2;
    float* KK = cc + 16 * 64 * 2;
    for (int u = bid; u < DEPTH * 64; u += nblk) {
        const int L = u >> 6, g = u & 63;
        __syncthreads();
        for (int i = tid; i < 2 * 17 * 64; i += NT) { const int dir = i / (17 * 64), dl = (i / 64) % 17, pp = i % 64; const int li = ((L * 2 + dir) * 64 + g) * 64 + pp;
            const float dt = expf(p.in[I_S5DT][(L * 2 + dir) * 64 + g]); const float x = p.in[I_S5LR][li] * dt * (float)dl, th = p.in[I_S5LI][li] * dt * (float)dl; const float mg = expf(x);
            ap[i * 2] = mg * cosf(th); ap[i * 2 + 1] = mg * sinf(th); }
        { const float* BB = (const float*)(ws + WS_S5P + L * S5P_STRIDE) + 32768;
          for (int i = tid; i < 2 * 64 * 32; i += NT) { const int dir = i / 2048, r = i % 2048; bb[i] = BB[(size_t)(dir * 4096 + g * 64) * 32 + r]; } }
        for (int i = tid; i < 16 * 64; i += NT) { cc[i * 2] = p.in[I_S5CR][((size_t)L * 64 + g) * 1024 + i]; cc[i * 2 + 1] = p.in[I_S5CI][((size_t)L * 64 + g) * 1024 + i]; }
        __syncthreads();
        if (nblk * 0 == 0) {
            const int dir = tid >> 8, dl = (tid >> 4) & 15, ib = ((tid >> 2) & 3) * 4, jb = (tid & 3) * 4;
            float acc[4][4];
#pragma unroll
            for (int a = 0; a < 4; ++a)
#pragma unroll
                for (int c = 0; c < 4; ++c) acc[a][c] = 0.f;
            for (int pp = 0; pp < 64; ++pp) { const float2 av = *(const float2*)(ap + ((dir * 17 + dl) * 64 + pp) * 2);
                const f32x4 b01 = *(const f32x4*)(bb + ((dir * 64 + pp) * 16 + jb) * 2), b23 = *(const f32x4*)(bb + ((dir * 64 + pp) * 16 + jb + 2) * 2);
                const float zr[4] = {av.x * b01.x - av.y * b01.y, av.x * b01.z - av.y * b01.w, av.x * b23.x - av.y * b23.y, av.x * b23.z - av.y * b23.w};
                const float zi[4] = {av.x * b01.y + av.y * b01.x, av.x * b01.w + av.y * b01.z, av.x * b23.y + av.y * b23.x, av.x * b23.w + av.y * b23.z};
#pragma unroll
                for (int a = 0; a < 4; ++a) { const float2 cv = *(const float2*)(cc + ((ib + a) * 64 + pp) * 2);
#pragma unroll
                    for (int c = 0; c < 4; ++c) acc[a][c] += cv.x * zr[c] - cv.y * zi[c]; } }
#pragma unroll
            for (int a = 0; a < 4; ++a)
#pragma unroll
                for (int c = 0; c < 4; ++c) KK[((dir * 16 + dl) * 16 + ib + a) * 16 + jb + c] = acc[a][c];
        }
        __syncthreads();
        bf16* T1 = (bf16*)(ws + WS_S5T1 + L * SZ_S5T1) + (size_t)g * 256 * 256; bf16* T2 = (bf16*)(ws + WS_S5T2 + L * SZ_S5T2) + (size_t)g * 256 * 512;
        for (int ch = tid; ch < 256 * 32; ch += NT) { const int n = ch >> 5, k0 = (ch & 31) * 8; const int dir = n >> 7, part = (n >> 6) & 1, pp = n & 63; const int tau = k0 >> 4, i0 = k0 & 15;
            const int ex = dir == 0 ? 15 - tau : tau; const float ar = ap[((dir * 17 + ex) * 64 + pp) * 2], ai = ap[((dir * 17 + ex) * 64 + pp) * 2 + 1];
            float v[8];
#pragma unroll
            for (int j = 0; j < 8; ++j) { const float br = bb[((dir * 64 + pp) * 16 + i0 + j) * 2], bi = bb[((dir * 64 + pp) * 16 + i0 + j) * 2 + 1]; v[j] = part == 0 ? ar * br - ai * bi : ar * bi + ai * br; }
            u32x4 w; w.x = pk2(v[0], v[1]); w.y = pk2(v[2], v[3]); w.z = pk2(v[4], v[5]); w.w = pk2(v[6], v[7]); *(u32x4*)(T1 + (size_t)n * 256 + k0) = w; }
        const float* dsk = p.in[I_S5D] + L * 1024 + g * 16;
        for (int ch = tid; ch < 256 * 64; ch += NT) { const int n = ch >> 6, k0 = (ch & 63) * 8; const int tau = n >> 4, i = n & 15;
            float v[8];
            if (k0 < 256) { const int dir = k0 >> 7, part = (k0 >> 6) & 1, p0 = k0 & 63; const int ex = dir == 0 ? tau + 1 : 16 - tau;
#pragma unroll
                for (int j = 0; j < 8; ++j) { const int pp = p0 + j; const float ar = ap[((dir * 17 + ex) * 64 + pp) * 2], ai = ap[((dir * 17 + ex) * 64 + pp) * 2 + 1];
                    const float cr = cc[(i * 64 + pp) * 2], ci = cc[(i * 64 + pp) * 2 + 1]; v[j] = part == 0 ? cr * ar - ci * ai : -(cr * ai + ci * ar); }
            } else { const int t2 = (k0 - 256) >> 4, i0 = k0 & 15;
#pragma unroll
                for (int j = 0; j < 8; ++j) { const int i2 = i0 + j; float a = 0.f;
                    if (t2 <= tau) a += KK[((0 * 16 + (tau - t2)) * 16 + i) * 16 + i2];
                    if (t2 >= tau) a += KK[((1 * 16 + (t2 - tau)) * 16 + i) * 16 + i2];
                    if (t2 == tau && i2 == i) a += dsk[i];
                    v[j] = a; } }
            u32x4 w; w.x = pk2(v[0], v[1]); w.y = pk2(v[2], v[3]); w.z = pk2(v[4], v[5]); w.w = pk2(v[6], v[7]); *(u32x4*)(T2 + (size_t)n * 512 + k0) = w; }
    }
}

namespace ml {
using bf16x8 = __attribute__((ext_vector_type(8))) short;
using s16x4  = __attribute__((ext_vector_type(4))) short;
typedef short v4i16_t __attribute__((ext_vector_type(4)));
constexpr int NET = 5;
constexpr int RS = 528, VRS = NET * 32, SRS = 144;
constexpr int OFF_Q = 0, OFF_K = 64 * RS, OFF_C = 2 * 64 * RS, OFF_V = OFF_C + NET * 16 * RS, OFF_VW = OFF_V + 64 * VRS, OFF_SM = OFF_VW + 64 * VRS, OFF_DEN = OFF_SM + 64 * SRS, LDS_END = OFF_DEN + 256;
static_assert(LDS_END <= 140 * 1024, "mLSTM LDS map");
__device__ __forceinline__ bf16x8 ldfrag(const LAS unsigned char* p) { return *(const LAS bf16x8*)p; }
__device__ __forceinline__ s16x4 trfrag(const LAS unsigned char* p) { return __builtin_bit_cast(s16x4, __builtin_amdgcn_ds_read_tr16_b64_v4i16((LAS v4i16_t*)p)); }
__device__ __forceinline__ bf16x8 cat4(s16x4 l, s16x4 h) { return (bf16x8){l[0], l[1], l[2], l[3], h[0], h[1], h[2], h[3]}; }
}
__device__ __forceinline__ void phase_mlstm(const P& p, int L, LAS unsigned char* lds, int bid, int nblk) { unsigned char* const ws = lp_(p.ws);
    using namespace ml;
    const int tid = tid_(), wave = __builtin_amdgcn_readfirstlane(tid >> 6), lane = tid & 63, l15 = lane & 15, quad = lane >> 4;
    const bf16* PROJ = (const bf16*)(ws + WS_RA + RA_PROJ); const bf16* QK = (const bf16*)(ws + WS_RA + RA_QK);
    const float* GATES = (const float*)(ws + WS_GATES); float* HML = (float*)(ws + WS_RA + RA_HML);
    const int tt = wave & 3, sh = wave >> 2;
    for (int task = bid; task < 128; task += nblk) {
        const int b = task >> 5, h = (task >> 3) & 3, dir = (task >> 2) & 1, es = task & 3;
        { unsigned z0 = 0u; asm volatile("" : "+v"(z0)); for (int i = tid; i < NET * 16 * RS / 16; i += NT) *(LAS u32x4*)(lds + OFF_C + i * 16) = (u32x4){z0, z0, z0, z0}; }
        f32x4 Cacc[2][NET];
#pragma unroll
        for (int a = 0; a < 2; ++a)
#pragma unroll
            for (int e = 0; e < NET; ++e) Cacc[a][e] = (f32x4){0.f, 0.f, 0.f, 0.f};
        float m_prev = 0.f;
        u32x4 rq[4], rk[4], rv; float rig, rfg;
#define ML_LOAD(c) do { _Pragma("unroll") for (int i = 0; i < 4; ++i) { const int id = tid + NT * i, j = id >> 5, ch = id & 31; const size_t m = (size_t)b * NTOK + tok_of(64 * (c) + j, dir); \
            rq[i] = *(const u32x4*)(QK + m * 2048 + h * 256 + ch * 8); rk[i] = *(const u32x4*)(QK + m * 2048 + 1024 + h * 256 + ch * 8); } \
        { const int j = tid >> 3, ch = tid & 7; const size_t m = (size_t)b * NTOK + tok_of(64 * (c) + j, dir); rv = *(const u32x4*)(PROJ + m * NPROJ + C_MLV + h * 256 + es * 64 + ch * 8); } \
        { const size_t m = (size_t)b * NTOK + tok_of(64 * (c) + lane, dir); rig = GATES[m * 16 + (2 * dir) * 4 + h]; rfg = GATES[m * 16 + (2 * dir + 1) * 4 + h]; } } while (0)
        ML_LOAD(0);
        __syncthreads();
        for (int c = 0; c < 36; ++c) {
            float bc = log_sigmoid(rfg);
            bc = wave_scan<false>(bc);
            const float ga = rig - bc; float cm = ga;
            cm = wave_scan<true>(cm);
            const float gM = fmaxf(m_prev, cm); const float M63 = rdlane(gM, 63), b63 = rdlane(bc, 63);
            const float gwin = __expf(m_prev - gM), gnrm = __expf(-(bc + gM)), gwS = __expf(ga - M63), decay = __expf(m_prev - M63);
            m_prev = b63 + M63;
#pragma unroll
            for (int i = 0; i < 4; ++i) { const int id = tid + NT * i, j = id >> 5, ch = id & 31; *(LAS u32x4*)(lds + OFF_Q + j * RS + ch * 16) = rq[i]; *(LAS u32x4*)(lds + OFF_K + j * RS + ch * 16) = rk[i]; }
            { const int j = tid >> 3, ch = tid & 7; const float wj = bperm(gwS, j);
                *(LAS u32x4*)(lds + OFF_V + j * VRS + ch * 16) = rv;
                u32x4 w; w.x = pk2(bflo(rv.x) * wj, bfhi(rv.x) * wj); w.y = pk2(bflo(rv.y) * wj, bfhi(rv.y) * wj); w.z = pk2(bflo(rv.z) * wj, bfhi(rv.z) * wj); w.w = pk2(bflo(rv.w) * wj, bfhi(rv.w) * wj);
                *(LAS u32x4*)(lds + OFF_VW + j * VRS + ch * 16) = w;
                if (ch == 0) { unsigned one = 0x3f80u, zz = 0u; asm volatile("" : "+v"(one), "+v"(zz));
                    *(LAS u32x4*)(lds + OFF_V + j * VRS + 128) = (u32x4){one, zz, zz, zz}; *(LAS u32x4*)(lds + OFF_V + j * VRS + 144) = (u32x4){zz, zz, zz, zz};
                    *(LAS u32x4*)(lds + OFF_VW + j * VRS + 128) = (u32x4){f2bf(wj), zz, zz, zz}; *(LAS u32x4*)(lds + OFF_VW + j * VRS + 144) = (u32x4){zz, zz, zz, zz}; } }
            if (c + 1 < 36) ML_LOAD(c + 1);
            __syncthreads();
            f32x4 S0 = {0.f, 0.f, 0.f, 0.f}, S1 = S0, H0 = S0, H1 = S0, H2 = S0;
            {   const LAS unsigned char* qa = lds + OFF_Q + (tt * 16 + l15) * RS + quad * 16;
                const LAS unsigned char* k0 = lds + OFF_K + ((2 * sh) * 16 + l15) * RS + quad * 16; const LAS unsigned char* k1 = k0 + 16 * RS;
                const LAS unsigned char* c0 = lds + OFF_C + ((3 * sh) * 16 + l15) * RS + quad * 16; const LAS unsigned char* c1 = c0 + 16 * RS; const LAS unsigned char* c2 = c0 + 32 * RS;
#pragma unroll
                for (int kk = 0; kk < 8; ++kk) { const bf16x8 a = ldfrag(qa + kk * 64);
                    S0 = __builtin_amdgcn_mfma_f32_16x16x32_bf16(a, ldfrag(k0 + kk * 64), S0, 0, 0, 0);
                    S1 = __builtin_amdgcn_mfma_f32_16x16x32_bf16(a, ldfrag(k1 + kk * 64), S1, 0, 0, 0);
                    H0 = __builtin_amdgcn_mfma_f32_16x16x32_bf16(a, ldfrag(c0 + kk * 64), H0, 0, 0, 0);
                    H1 = __builtin_amdgcn_mfma_f32_16x16x32_bf16(a, ldfrag(c1 + kk * 64), H1, 0, 0, 0);
                    if (sh == 0) H2 = __builtin_amdgcn_mfma_f32_16x16x32_bf16(a, ldfrag(c2 + kk * 64), H2, 0, 0, 0); } }
            float Mt[4], wt[4];
#pragma unroll
            for (int i = 0; i < 4; ++i) { const int t = tt * 16 + quad * 4 + i; Mt[i] = bperm(gM, t); wt[i] = bperm(gwin, t); }
            {   const int s0 = (2 * sh) * 16 + l15, s1 = s0 + 16; const float a0 = bperm(ga, s0), a1 = bperm(ga, s1);
#pragma unroll
                for (int i = 0; i < 4; ++i) { const int t = tt * 16 + quad * 4 + i;
                    const float v0 = s0 <= t ? S0[i] * __expf(a0 - Mt[i]) : 0.f, v1 = s1 <= t ? S1[i] * __expf(a1 - Mt[i]) : 0.f;
                    *(LAS unsigned short*)(lds + OFF_SM + t * SRS + s0 * 2) = (unsigned short)f2bf(v0); *(LAS unsigned short*)(lds + OFF_SM + t * SRS + s1 * 2) = (unsigned short)f2bf(v1);
                    H0[i] *= wt[i]; H1[i] *= wt[i]; H2[i] *= wt[i]; } }
            __syncthreads();
            {   const LAS unsigned char* sa = lds + OFF_SM + (tt * 16 + l15) * SRS + quad * 16;
                const LAS unsigned char* vb = lds + OFF_V + (quad * 8 + (l15 >> 2)) * VRS + (3 * sh) * 32 + (lane & 3) * 8;
#pragma unroll
                for (int k2 = 0; k2 < 2; ++k2) { const bf16x8 a = ldfrag(sa + k2 * 64);
                    H0 = __builtin_amdgcn_mfma_f32_16x16x32_bf16(a, cat4(trfrag(vb + k2 * 32 * VRS), trfrag(vb + k2 * 32 * VRS + 4 * VRS)), H0, 0, 0, 0);
                    H1 = __builtin_amdgcn_mfma_f32_16x16x32_bf16(a, cat4(trfrag(vb + k2 * 32 * VRS + 32), trfrag(vb + k2 * 32 * VRS + 4 * VRS + 32)), H1, 0, 0, 0);
                    if (sh == 0) H2 = __builtin_amdgcn_mfma_f32_16x16x32_bf16(a, cat4(trfrag(vb + k2 * 32 * VRS + 64), trfrag(vb + k2 * 32 * VRS + 4 * VRS + 64)), H2, 0, 0, 0); } }
            if (sh == 1 && l15 == 0) {
#pragma unroll
                for (int i = 0; i < 4; ++i) *(LAS float*)(lds + OFF_DEN + (tt * 16 + quad * 4 + i) * 4) = H1[i]; }
            {   const LAS unsigned char* va = lds + OFF_VW + (quad * 8 + (l15 >> 2)) * VRS + (lane & 3) * 8;
                const LAS unsigned char* kb = lds + OFF_K + (quad * 8 + (l15 >> 2)) * RS + (2 * wave) * 32 + (lane & 3) * 8;
#pragma unroll
                for (int a = 0; a < 2; ++a)
#pragma unroll
                    for (int e = 0; e < NET; ++e) Cacc[a][e] = Cacc[a][e] * decay;
#pragma unroll
                for (int k2 = 0; k2 < 2; ++k2) {
                    bf16x8 bfr[2];
#pragma unroll
                    for (int a = 0; a < 2; ++a) bfr[a] = cat4(trfrag(kb + k2 * 32 * RS + a * 32), trfrag(kb + k2 * 32 * RS + 4 * RS + a * 32));
#pragma unroll
                    for (int e = 0; e < NET; ++e) { const bf16x8 af = cat4(trfrag(va + k2 * 32 * VRS + e * 32), trfrag(va + k2 * 32 * VRS + 4 * VRS + e * 32));
#pragma unroll
                        for (int a = 0; a < 2; ++a) Cacc[a][e] = __builtin_amdgcn_mfma_f32_16x16x32_bf16(bfr[a], af, Cacc[a][e], 0, 0, 0); } }
#pragma unroll
                for (int a = 0; a < 2; ++a)
#pragma unroll
                    for (int e = 0; e < NET; ++e)
                        { u32x2 w; w.x = pk2(Cacc[a][e][0], Cacc[a][e][1]); w.y = pk2(Cacc[a][e][2], Cacc[a][e][3]);
                          *(LAS u32x2*)(lds + OFF_C + (e * 16 + l15) * RS + ((2 * wave + a) * 16 + quad * 4) * 2) = w; } }
            __syncthreads();
            {
#pragma unroll
                for (int i = 0; i < 4; ++i) { const int t = tt * 16 + quad * 4 + i; const float den = *(const LAS float*)(lds + OFF_DEN + t * 4); const float nr = bperm(gnrm, t);
                    const float inv = __builtin_amdgcn_rcpf(fmaxf(fabsf(den), nr)); const size_t m = (size_t)b * NTOK + tok_of(64 * c + t, dir);
                    float* o = HML + ((size_t)dir * MROWS + m) * 1024 + h * 256 + es * 64 + (3 * sh) * 16 + l15; o[0] = H0[i] * inv; if (sh == 0) { o[16] = H1[i] * inv; o[32] = H2[i] * inv; } } }
        }
#undef ML_LOAD
        __syncthreads();
    }
}
__device__ __forceinline__ void phase_mlpost(const P& p, int L, int bid, int nblk) { unsigned char* const ws = lp_(p.ws);
    const int tid = tid_(), wave = tid >> 6, lane = tid & 63;
    const bf16* PROJ = (const bf16*)(ws + WS_RA + RA_PROJ); const float* HML = (const float*)(ws + WS_RA + RA_HML); bf16* YA = (bf16*)(ws + WS_RA + RA_YA);
    const float* ng = p.in[I_MLNG] + L * 1024;
    constexpr int NI = MROWS * 4; const int stride = nblk * 8;
    for (int i0 = bid * 8 + wave; i0 < NI; i0 += 4 * stride) {
        f32x4 va[4], vb[4]; u32x2 oo[4]; int mm[4], cc[4]; bool ok[4];
#pragma unroll
        for (int k = 0; k < 4; ++k) { const int i = i0 + k * stride; ok[k] = i < NI; const int ii = ok[k] ? i : i0; mm[k] = ii >> 2; cc[k] = (ii & 3) * 256 + 4 * lane;
            va[k] = *(const f32x4*)(HML + (size_t)mm[k] * 1024 + cc[k]); vb[k] = *(const f32x4*)(HML + ((size_t)MROWS + mm[k]) * 1024 + cc[k]); oo[k] = *(const u32x2*)(PROJ + (size_t)mm[k] * NPROJ + C_MLO + cc[k]); }
#pragma unroll
        for (int k = 0; k < 4; ++k) { const f32x4 v = va[k] + vb[k];
            const float rstd = rsqrtf(wave_sum(v.x * v.x + v.y * v.y + v.z * v.z + v.w * v.w) * (1.f / 256.f) + EPS);
            const f32x4 g = *(const f32x4*)(ng + cc[k]);
            u32x2 w; w.x = pk2(sigmoidf_(bflo(oo[k].x)) * v.x * rstd * g.x, sigmoidf_(bfhi(oo[k].x)) * v.y * rstd * g.y);
            w.y = pk2(sigmoidf_(bflo(oo[k].y)) * v.z * rstd * g.z, sigmoidf_(bfhi(oo[k].y)) * v.w * rstd * g.w);
            if (ok[k]) *(u32x2*)(YA + (size_t)mm[k] * 1024 + cc[k]) = w; }
    }
}

namespace da {
using bf16x8 = __attribute__((ext_vector_type(8))) short;
using s16x4  = __attribute__((ext_vector_type(4))) short;
using f32x16 = __attribute__((ext_vector_type(16))) float;
constexpr int KVBLK = 64, LDQ = 1024, LDK = 1024, LDV = NPROJ;
constexpr float SCALE = 0.125f, THR = 8.f;
constexpr int SHM_V = KVBLK * 128 * 2, SHM_K = KVBLK * 128 * 2;
constexpr int NBUF = 4;
constexpr int OFF_WS = NBUF * (SHM_V + SHM_K), OFF_X = 0, OFF_SG = 65536;
#define KSWZ(row, colB) ((row) * 256 + ((colB) ^ (((row) & 7) << 4)))
#define SBAR() __builtin_amdgcn_sched_barrier(0)
__device__ __forceinline__ int crow(int r, int hi) { return (r & 3) + 8 * (r >> 2) + 4 * hi; }
__device__ __forceinline__ unsigned cvtpk(float lo, float hi) { unsigned r; asm volatile("v_cvt_pk_bf16_f32 %0, %1, %2" : "=v"(r) : "v"(lo), "v"(hi)); return r; }
__device__ __forceinline__ void partialSM(f32x16& p0, f32x16& p1, float mnC) {
  constexpr float C = SCALE * 1.4426950408889634f;
#pragma unroll
  for (int r = 0; r < 16; ++r) p0[r] = fmaf(p0[r], C, mnC);
#pragma unroll
  for (int r = 0; r < 16; ++r) p1[r] = fmaf(p1[r], C, mnC);
#pragma unroll
  for (int r = 0; r < 16; ++r) p0[r] = __builtin_amdgcn_exp2f(p0[r]);
}
__device__ __forceinline__ void softmax_tile(f32x16& p0, f32x16& p1, float mnC, float& l_reg, bf16x8& pa0, bf16x8& pa1, bf16x8& pa2, bf16x8& pa3) {
  if (mnC < -28.f) {
#pragma unroll
    for (int r = 0; r < 16; ++r) { p0[r] += mnC; p1[r] += mnC; } }
#pragma unroll
  for (int r = 0; r < 16; ++r) { p0[r] = __builtin_amdgcn_exp2f(p0[r]); p1[r] = __builtin_amdgcn_exp2f(p1[r]); }
  float ps = 0;
#pragma unroll
  for (int r = 0; r < 16; ++r) ps += p0[r] + p1[r];
  { auto rr = __builtin_amdgcn_permlane32_swap(__float_as_uint(ps), __float_as_uint(ps), false, false);
    ps = __uint_as_float(rr[0]) + __uint_as_float(rr[1]); }
  l_reg += ps;
#define PK4(Pv, BASE, OUT) do { unsigned a0 = cvtpk(Pv[BASE + 0], Pv[BASE + 1]), a1 = cvtpk(Pv[BASE + 2], Pv[BASE + 3]);   \
    unsigned b0 = cvtpk(Pv[BASE + 4], Pv[BASE + 5]), b1 = cvtpk(Pv[BASE + 6], Pv[BASE + 7]);                              \
    auto r0 = __builtin_amdgcn_permlane32_swap(a0, b0, false, false); auto r1 = __builtin_amdgcn_permlane32_swap(a1, b1, false, false); \
    u32x4 w = {r0[0], r1[0], r0[1], r1[1]}; OUT = *reinterpret_cast<bf16x8*>(&w); } while (0)
  PK4(p0, 0, pa0); PK4(p0, 8, pa1); PK4(p1, 0, pa2); PK4(p1, 8, pa3);
#undef PK4
}
__device__ __forceinline__ void finishSM(f32x16& p0, f32x16& p1, float& l_reg, bf16x8& pa0, bf16x8& pa1, bf16x8& pa2, bf16x8& pa3) {
#pragma unroll
  for (int r = 0; r < 16; ++r) p1[r] = __builtin_amdgcn_exp2f(p1[r]);
  float ps = 0;
#pragma unroll
  for (int r = 0; r < 16; ++r) ps += p0[r];
#pragma unroll
  for (int r = 0; r < 16; ++r) ps += p1[r];
  { auto rr = __builtin_amdgcn_permlane32_swap(__float_as_uint(ps), __float_as_uint(ps), false, false);
    ps = __uint_as_float(rr[0]) + __uint_as_float(rr[1]); }
  l_reg += ps;
#define PK4(Pv, BASE, OUT) do { unsigned a0 = cvtpk(Pv[BASE + 0], Pv[BASE + 1]), a1 = cvtpk(Pv[BASE + 2], Pv[BASE + 3]);   \
    unsigned b0 = cvtpk(Pv[BASE + 4], Pv[BASE + 5]), b1 = cvtpk(Pv[BASE + 6], Pv[BASE + 7]);                              \
    auto r0 = __builtin_amdgcn_permlane32_swap(a0, b0, false, false); auto r1 = __builtin_amdgcn_permlane32_swap(a1, b1, false, false); \
    u32x4 w = {r0[0], r1[0], r0[1], r1[1]}; OUT = *reinterpret_cast<bf16x8*>(&w); } while (0)
  PK4(p0, 0, pa0); PK4(p0, 8, pa1); PK4(p1, 0, pa2); PK4(p1, 8, pa3);
#undef PK4
}
__device__ __forceinline__ void qkt(f32x16& p0, f32x16& p1, const char* Ks, const bf16x8* qr, int r32, int hi, int comp) {
  p0 = f32x16{}; p1 = f32x16{};
#pragma unroll
  for (int d0 = 0; d0 < 4; ++d0) { const int cb = (comp * 64 + d0 * 16 + hi * 8) * 2;
    bf16x8 b0 = *reinterpret_cast<const bf16x8*>(Ks + KSWZ(r32, cb));
    bf16x8 b1 = *reinterpret_cast<const bf16x8*>(Ks + KSWZ(32 + r32, cb));
    p0 = __builtin_amdgcn_mfma_f32_32x32x16_bf16(b0, qr[d0], p0, 0, 0, 0);
    p1 = __builtin_amdgcn_mfma_f32_32x32x16_bf16(b1, qr[d0], p1, 0, 0, 0); }
}
__device__ __forceinline__ int v_st(int k, int c) { const int kk = (k & ~0xC) | ((k & 4) << 1) | ((k & 8) >> 1); return ((kk >> 3) * 4 + (c >> 5)) * 512 + ((kk & 7) * 32 + (c & 31)) * 2; }
__device__ __forceinline__ int v_rd_base(int lane) { return ((lane & 3) << 3) | (((lane >> 2) & 3) << 6) | (((lane >> 4) & 1) << 5) | (((lane >> 5) & 1) << 8); }
constexpr int v_rd_off(int d0, int ks, int half) { return d0 * 512 + ks * 4096 + half * 2048; }
template <int OFF> __device__ __forceinline__ s16x4 tr_read(int vb) {
  s16x4 r; asm volatile("ds_read_b64_tr_b16 %0, %1 offset:%2" : "=&v"(r) : "v"(vb), "i"(OFF) : "memory"); return r;
}
template <int D0> __device__ __forceinline__ void pv_one(f32x16& od, int vb, bf16x8 pa0, bf16x8 pa1, bf16x8 pa2, bf16x8 pa3) {
  const s16x4 l0 = tr_read<v_rd_off(D0, 0, 0)>(vb), h0 = tr_read<v_rd_off(D0, 0, 1)>(vb), l1 = tr_read<v_rd_off(D0, 1, 0)>(vb), h1 = tr_read<v_rd_off(D0, 1, 1)>(vb);
  const s16x4 l2 = tr_read<v_rd_off(D0, 2, 0)>(vb), h2 = tr_read<v_rd_off(D0, 2, 1)>(vb), l3 = tr_read<v_rd_off(D0, 3, 0)>(vb), h3 = tr_read<v_rd_off(D0, 3, 1)>(vb);
  asm volatile("s_waitcnt lgkmcnt(0)" ::: "memory"); SBAR();
#define PK(Lx, Hx) (bf16x8){Lx[0], Lx[1], Lx[2], Lx[3], Hx[0], Hx[1], Hx[2], Hx[3]}
  od = __builtin_amdgcn_mfma_f32_32x32x16_bf16(pa0, PK(l0, h0), od, 0, 0, 0);
  od = __builtin_amdgcn_mfma_f32_32x32x16_bf16(pa1, PK(l1, h1), od, 0, 0, 0);
  od = __builtin_amdgcn_mfma_f32_32x32x16_bf16(pa2, PK(l2, h2), od, 0, 0, 0);
  od = __builtin_amdgcn_mfma_f32_32x32x16_bf16(pa3, PK(l3, h3), od, 0, 0, 0);
#undef PK
}
__device__ __forceinline__ void pv_d0(f32x16* o, int vb, bf16x8 pa0, bf16x8 pa1, bf16x8 pa2, bf16x8 pa3) {
  s16x4 fa[8], fb[8];
#define PV_RD(f, D0) do { f[0] = tr_read<v_rd_off(D0, 0, 0)>(vb); f[1] = tr_read<v_rd_off(D0, 0, 1)>(vb); f[2] = tr_read<v_rd_off(D0, 1, 0)>(vb); f[3] = tr_read<v_rd_off(D0, 1, 1)>(vb); \
    f[4] = tr_read<v_rd_off(D0, 2, 0)>(vb); f[5] = tr_read<v_rd_off(D0, 2, 1)>(vb); f[6] = tr_read<v_rd_off(D0, 3, 0)>(vb); f[7] = tr_read<v_rd_off(D0, 3, 1)>(vb); } while (0)
#define PV_PK(Lx, Hx) (bf16x8){Lx[0], Lx[1], Lx[2], Lx[3], Hx[0], Hx[1], Hx[2], Hx[3]}
#define PV_MM(od, f) do { od = __builtin_amdgcn_mfma_f32_32x32x16_bf16(pa0, PV_PK(f[0], f[1]), od, 0, 0, 0); od = __builtin_amdgcn_mfma_f32_32x32x16_bf16(pa1, PV_PK(f[2], f[3]), od, 0, 0, 0); \
    od = __builtin_amdgcn_mfma_f32_32x32x16_bf16(pa2, PV_PK(f[4], f[5]), od, 0, 0, 0); od = __builtin_amdgcn_mfma_f32_32x32x16_bf16(pa3, PV_PK(f[6], f[7]), od, 0, 0, 0); } while (0)
  SBAR(); PV_RD(fa, 0); PV_RD(fb, 1);
  asm volatile("s_waitcnt lgkmcnt(8)" ::: "memory"); SBAR(); PV_MM(o[0], fa); SBAR();
  PV_RD(fa, 2); asm volatile("s_waitcnt lgkmcnt(8)" ::: "memory"); SBAR(); PV_MM(o[1], fb); SBAR();
  PV_RD(fb, 3); asm volatile("s_waitcnt lgkmcnt(8)" ::: "memory"); SBAR(); PV_MM(o[2], fa); SBAR();
  asm volatile("s_waitcnt lgkmcnt(0)" ::: "memory"); SBAR(); PV_MM(o[3], fb); SBAR();
#undef PV_RD
#undef PV_PK
#undef PV_MM
}
__device__ __forceinline__ void attn_unit(const bf16* __restrict__ Qb, const bf16* __restrict__ Kh, const bf16* __restrict__ Vh, bf16* __restrict__ Ob, int seq, char* lds,
                                          float lam, float onorm, const float* __restrict__ subg, float mnC) {
  const int tid = tid_(), wid = __builtin_amdgcn_readfirstlane(tid >> 6), lane = tid & 63, r32 = lane & 31, hi = lane >> 5, comp = wid >> 2, wq = wid & 3;
  char* V_lds = lds; char* K_lds = lds + NBUF * SHM_V;
  float* wsl = (float*)(lds + OFF_WS) + wid * 64; float* li_l = wsl;
  float l_reg = 0; f32x16 o[4] = {}; bf16x8 qr[4];
  const bf16* Qw = Qb + (long)(wq * 32 + r32) * LDQ + comp * 64 + hi * 8;
#pragma unroll
  for (int d0 = 0; d0 < 4; ++d0) qr[d0] = *reinterpret_cast<const bf16x8*>(Qw + d0 * 16);
  const int sr = tid >> 4, sc = (tid & 15) * 8, vst0 = v_st(sr, sc), vst1 = v_st(32 + sr, sc);
  const int vb0 = (int)(uintptr_t)V_lds + v_rd_base(lane);
  struct { bf16x8 vs0, vs1, ks0, ks1; } sr_[2];
#define SLOAD(i, k0) do { sr_[i].vs0 = *reinterpret_cast<const bf16x8*>(&Vh[(long)((k0) + sr) * LDV + sc]); sr_[i].vs1 = *reinterpret_cast<const bf16x8*>(&Vh[(long)((k0) + 32 + sr) * LDV + sc]); \
    sr_[i].ks0 = *reinterpret_cast<const bf16x8*>(&Kh[(long)((k0) + sr) * LDK + sc]); sr_[i].ks1 = *reinterpret_cast<const bf16x8*>(&Kh[(long)((k0) + 32 + sr) * LDK + sc]); } while (0)
#define SWRITE(b, i) do { *(bf16x8*)(V_lds + (b) * SHM_V + vst0) = sr_[i].vs0; *(bf16x8*)(V_lds + (b) * SHM_V + vst1) = sr_[i].vs1; const int kc = sc * 2; \
    *(bf16x8*)(K_lds + (b) * SHM_K + KSWZ(sr, kc)) = sr_[i].ks0; *(bf16x8*)(K_lds + (b) * SHM_K + KSWZ(32 + sr, kc)) = sr_[i].ks1; } while (0)
#define SWAIT() asm volatile("s_waitcnt vmcnt(4)" ::: "memory")
#define BARL() asm volatile("s_waitcnt lgkmcnt(0)\n\ts_barrier" ::: "memory")
  f32x16 p0, p1; bf16x8 pa0, pa1, pa2, pa3; const int NTL = seq / KVBLK;
  SLOAD(0, 0); SLOAD(1, KVBLK);
  asm volatile("s_waitcnt vmcnt(4)" ::: "memory"); SWRITE(0, 0);
  asm volatile("s_waitcnt vmcnt(0)" ::: "memory"); SWRITE(1, 1);
  if (2 < NTL) SLOAD(0, 2 * KVBLK);
  if (3 < NTL) SLOAD(1, 3 * KVBLK);
  BARL();
  if (comp == 1) { BARL(); __builtin_amdgcn_s_setprio(1); }
  SBAR(); qkt(p0, p1, K_lds, qr, r32, hi, comp); SBAR();
  BARL();
  for (int j = 0; j < NTL; j += 2) {
    SBAR(); softmax_tile(p0, p1, mnC, l_reg, pa0, pa1, pa2, pa3); SBAR();
    if (j + 2 < NTL) { if (j + 3 < NTL) SWAIT(); else asm volatile("s_waitcnt vmcnt(0)" ::: "memory"); SWRITE((j + 2) & 3, 0); if (j + 4 < NTL) SLOAD(0, (j + 4) * KVBLK); }
    BARL();
    SBAR(); qkt(p0, p1, K_lds + ((j + 1) & 3) * SHM_K, qr, r32, hi, comp);
    pv_d0(o, vb0 + (j & 3) * SHM_V, pa0, pa1, pa2, pa3); SBAR();
    BARL();
    SBAR(); softmax_tile(p0, p1, mnC, l_reg, pa0, pa1, pa2, pa3); SBAR();
    if (j + 3 < NTL) { if (j + 4 < NTL) SWAIT(); else asm volatile("s_waitcnt vmcnt(0)" ::: "memory"); SWRITE((j + 3) & 3, 1); if (j + 5 < NTL) SLOAD(1, (j + 5) * KVBLK); }
    BARL();
    SBAR(); if (j + 2 < NTL) qkt(p0, p1, K_lds + ((j + 2) & 3) * SHM_K, qr, r32, hi, comp);
    pv_d0(o, vb0 + ((j + 1) & 3) * SHM_V, pa0, pa1, pa2, pa3); SBAR();
    if (j + 2 < NTL) BARL();
  }
  if (comp == 0) BARL(); else __builtin_amdgcn_s_setprio(0);
  BARL();
  if (hi == 0) li_l[r32] = l_reg; asm volatile("s_waitcnt lgkmcnt(0)" ::: "memory");
  float rli[16];
#pragma unroll
  for (int r = 0; r < 16; ++r) rli[r] = __builtin_amdgcn_rcpf(li_l[crow(r, hi)]) * (comp ? lam : 1.f);
  float* X = (float*)(lds + OFF_X);
  if (comp == 1) {
#pragma unroll
    for (int r = 0; r < 16; ++r)
#pragma unroll
      for (int d0 = 0; d0 < 4; ++d0) X[(wq * 32 + crow(r, hi)) * 128 + d0 * 32 + r32] = o[d0][r] * rli[r];
  }
  __syncthreads();
  unsigned short* Sg = (unsigned short*)(lds + OFF_SG);
  if (comp == 0) {
    float gsub[4];
#pragma unroll
    for (int d0 = 0; d0 < 4; ++d0) gsub[d0] = subg[d0 * 32 + r32] * onorm;
#pragma unroll
    for (int r = 0; r < 16; ++r) { const int row = wq * 32 + crow(r, hi); float ss = 0.f; float v[4];
#pragma unroll
      for (int d0 = 0; d0 < 4; ++d0) { v[d0] = o[d0][r] * rli[r] - X[row * 128 + d0 * 32 + r32]; ss += v[d0] * v[d0]; }
      ss += xorl<1>(ss); ss += xorl<2>(ss); ss += xorl<4>(ss); ss += xorl<8>(ss); ss += xorl<16>(ss);
      const float rstd = rsqrtf(ss * (1.f / 128.f) + EPS);
#pragma unroll
      for (int d0 = 0; d0 < 4; ++d0) Sg[row * 128 + d0 * 32 + r32] = (unsigned short)f2bf(v[d0] * rstd * gsub[d0]); }
  }
  __syncthreads();
#pragma unroll
  for (int i = 0; i < 4; ++i) { const int c = tid + NT * i, row = c >> 4, cc = c & 15; *(u32x4*)(Ob + (long)row * 1024 + cc * 8) = *(const u32x4*)(Sg + row * 128 + cc * 8); }
  __syncthreads();
#undef SLOAD
#undef SWRITE
#undef SWAIT
#undef BARL
}
#undef KSWZ
#undef SBAR
}
__device__ __forceinline__ void phase_attn(const P& p, int L, unsigned char* lds, int bid, int nblk) { unsigned char* const ws = lp_(p.ws);
    const bf16* PROJ = (const bf16*)(ws + WS_RA + RA_PROJ); const bf16* QN = (const bf16*)(ws + WS_RA + RA_QN); const bf16* KN = (const bf16*)(ws + WS_RA + RA_KN);
    bf16* YC = (bf16*)(ws + WS_RA + RA_YC);
    const float lam_init = 0.8f - 0.6f * expf(-0.3f * (float)L);
    float d1 = 0.f, d2 = 0.f;
    for (int k = 0; k < 64; ++k) { d1 += p.in[I_LQ1][L * 64 + k] * p.in[I_LK1][L * 64 + k]; d2 += p.in[I_LQ2][L * 64 + k] * p.in[I_LK2][L * 64 + k]; }
    const float lam = expf(d1) - expf(d2) + lam_init;
    const float* subg = p.in[I_SUBG] + L * 128;
    float gqm = 0.f, gkm = 0.f;
    for (int k = 0; k < 64; ++k) { gqm = fmaxf(gqm, fabsf(p.in[I_DAQG][L * 64 + k])); gkm = fmaxf(gkm, fabsf(p.in[I_DAKG][L * 64 + k])); }
    const float mnC = -fminf(8.f * gqm * gkm, 30.f) * 1.4426950408889634f;
    unsigned* qctr = (unsigned*)(ws + WS_CTL) + CW_ATTNQ + L * 64; int* qslot = (int*)(lds + LDS_QSLOT);
    for (;;) {
        if (tid_() == 0) *qslot = (int)__hip_atomic_fetch_add(qctr, 1u, __ATOMIC_RELAXED, __HIP_MEMORY_SCOPE_AGENT);
        __syncthreads();
        const int u = *qslot;
        if (u >= (L == DEPTH - 1 ? 512 : 576)) break;
        int bh, n0, seq;
        if (u < 512) { bh = u >> 4; n0 = CTX + (u & 15) * 128; seq = NTOK; } else { const int v = u - 512; bh = v >> 1; n0 = (v & 1) * 128; seq = CTX; }
        const int b = bh >> 3, h = bh & 7; const size_t m0 = (size_t)b * NTOK;
        da::attn_unit(QN + (m0 + n0) * 1024 + h * 128, KN + m0 * 1024 + h * 128, PROJ + m0 * NPROJ + C_DAV + h * 128, YC + (m0 + n0) * 1024 + h * 128, seq, (char*)lds, lam, 1.f - lam_init, subg, mnC);
    }
}

__device__ __forceinline__ void phase_norm2(const P& p, int L, unsigned char* lds, int bid, int nblk, int rmode, int cofs = 0) { unsigned char* const ws = lp_(p.ws);
    const int tid = tid_(), wave = tid >> 6, lane = tid & 63;
    const float* g2 = p.in[I_N2G] + L * DM; const float* rb = p.in[I_RB];
    float* rwt = (float*)lds;
    { const f32x4* src = (const f32x4*)p.in[I_RW];
#pragma unroll 4
      for (int i = 0; i < 16; ++i) { const int id = tid + NT * i, d = id >> 2, q4 = (id & 3) * 4; const f32x4 w = src[id];
          rwt[(q4 + 0) * DM + d] = w.x; rwt[(q4 + 1) * DM + d] = w.y; rwt[(q4 + 2) * DM + d] = w.z; rwt[(q4 + 3) * DM + d] = w.w; }
      __syncthreads(); }
    unsigned* cnt = (unsigned*)(ws + WS_CTL) + CW_MOECNT + L * 1024 + cofs;
    bf16* XG = (bf16*)(ws + WS_RA);
    const int nrows = rmode == 1 ? NB * SEQ : (rmode == 2 ? NB * CTX : MROWS);
    const int rpb = (nrows + nblk - 1) / nblk; int crs = -1; f32x4 cA[8], cB[8];
    for (int r = bid * rpb + wave; r < min(nrows, (bid + 1) * rpb); r += 8) {
        const int m = rmode == 1 ? (r / SEQ) * NTOK + CTX + (r % SEQ) : (rmode == 2 ? (r / CTX) * NTOK + (r % CTX) : r);
        const int rs = __builtin_amdgcn_readfirstlane(row_sel(m));
        if (rs != crs) { crs = rs; const float* md = (const float*)(ws + WS_MOD) + ((size_t)L * 5 + rs) * (6 * DM);
#pragma unroll
            for (int j = 0; j < 8; ++j) { const int c = 4 * lane + 256 * j; cA[j] = *(const f32x4*)(g2 + c) * (*(const f32x4*)(md + 4 * DM + c) + 1.f); cB[j] = *(const f32x4*)(md + 3 * DM + c); } }
        const bf16* z = (const bf16*)(ws + WS_Z) + (size_t)m * DM;
        f32x4 v[8]; float ss = 0.f;
#pragma unroll
        for (int j = 0; j < 8; ++j) { const u32x2 z2 = *(const u32x2*)(z + 4 * lane + 256 * j); v[j] = (f32x4){bflo(z2.x), bfhi(z2.x), bflo(z2.y), bfhi(z2.y)}; ss += v[j].x * v[j].x + v[j].y * v[j].y + v[j].z * v[j].z + v[j].w * v[j].w; }
        const float rstd = rsqrtf(wave_sum(ss) * (1.f / DM) + EPS);
        float lg[16];
#pragma unroll
        for (int e = 0; e < 16; ++e) lg[e] = 0.f;
#pragma unroll
        for (int j = 0; j < 8; ++j) { const int c = 4 * lane + 256 * j;
            v[j] = v[j] * rstd * cA[j] + cB[j];
#pragma unroll
            for (int q = 0; q < 16; ++q) { const f32x4 w4 = *(const f32x4*)(rwt + q * DM + c); lg[q] += v[j].x * w4.x + v[j].y * w4.y + v[j].z * w4.z + v[j].w * w4.w; } }
        { const bool h5 = lane & 32, h4 = lane & 16, h3 = lane & 8, h2 = lane & 4; float r8[8], r4[4], r2[2], r1;
#pragma unroll
          for (int i = 0; i < 8; ++i) { const float keep = h5 ? lg[i + 8] : lg[i], send = h5 ? lg[i] : lg[i + 8]; r8[i] = keep + xor32(send, h5); }
#pragma unroll
          for (int i = 0; i < 4; ++i) { const float keep = h4 ? r8[i + 4] : r8[i], send = h4 ? r8[i] : r8[i + 4]; r4[i] = keep + xorl<16>(send); }
#pragma unroll
          for (int i = 0; i < 2; ++i) { const float keep = h3 ? r4[i + 2] : r4[i], send = h3 ? r4[i] : r4[i + 2]; r2[i] = keep + xorl<8>(send); }
          { const float keep = h2 ? r2[1] : r2[0], send = h2 ? r2[0] : r2[1]; r1 = keep + xorl<4>(send); }
          r1 += xorl<2>(r1); r1 += xorl<1>(r1);
          lg[0] = r1; }
        float score[16], sel[16];
        {
            const float mylg = bperm(lg[0], 4 * (lane & 15)); const float mysc = 1.f / (1.f + expf(-mylg));
#pragma unroll
            for (int e = 0; e < 16; ++e) { score[e] = rdlane(mysc, e); sel[e] = score[e] + rb[e]; } }
        int gi = 0; float gbest = -1e30f;
#pragma unroll
        for (int g = 0; g < 4; ++g) { const float a = sel[4 * g], b = sel[4 * g + 1], c = sel[4 * g + 2], d = sel[4 * g + 3];
            const float hi1 = fmaxf(a, b), lo1 = fminf(a, b), hi2 = fmaxf(c, d), lo2 = fminf(c, d);
            const float top = fmaxf(hi1, hi2), second = fmaxf(fminf(hi1, hi2), (hi1 >= hi2) ? lo1 : lo2);
            const float gs = top + second; if (gs > gbest) { gbest = gs; gi = g; } }
        int e0 = 0, e1 = 0; float b0 = -1e30f, b1 = -1e30f, w0 = 0.f, w1 = 0.f;
#pragma unroll
        for (int e = 0; e < 16; ++e) { const bool in = (e >> 2) == gi; const float sv = sel[e];
            if (in && sv > b0) { b1 = b0; e1 = e0; w1 = w0; b0 = sv; e0 = e; w0 = score[e]; }
            else if (in && sv > b1) { b1 = sv; e1 = e; w1 = score[e]; } }
        const float wsum = w0 + w1; w0 /= wsum; w1 /= wsum;
        unsigned p0 = 0, p1 = 0;
        if (lane == 0) { p0 = atomicAdd(cnt + e0 * 64, 1u); p1 = atomicAdd(cnt + e1 * 64, 1u); }
        p0 = __builtin_amdgcn_readfirstlane(p0); p1 = __builtin_amdgcn_readfirstlane(p1);
        const int s0 = e0 * ECAP + (int)p0, s1 = e1 * ECAP + (int)p1;
        if (lane == 0) { int* rt = (int*)(ws + WS_ROUTE) + (size_t)m * 8; rt[0] = e0; rt[1] = e1; rt[2] = __float_as_int(w0); rt[3] = __float_as_int(w1); rt[4] = s0; rt[5] = s1; }
#pragma unroll
        for (int j = 0; j < 8; ++j) { const int c = 4 * lane + 256 * j; u32x2 w; w.x = pk2(v[j].x, v[j].y); w.y = pk2(v[j].z, v[j].w);
            *(u32x2*)(XG + (size_t)s0 * DM + c) = w; *(u32x2*)(XG + (size_t)s1 * DM + c) = w; }
    }
}

__device__ __forceinline__ void phase_inproj(const P& p, int L, LAS unsigned char* lds, int bid, int nblk) { unsigned char* const ws = lp_(p.ws);
    pg8::Gemm g{(const bf16*)(ws + WS_H), (const bf16*)(ws + WS_WIN + L * SZ_WIN), MROWS, NPADIN, DM}; pg8::StaticOrder S; S.init(MROWS, NPADIN, nblk, bid);
    pg8::EpiInproj E{(bf16*)(ws + WS_RA + RA_PROJ), p.in[I_BIN] + (size_t)L * IN_COLS, (bf16*)(ws + WS_RA + RA_S5A), (bf16*)(ws + WS_RA + RA_QN), (bf16*)(ws + WS_RA + RA_KN),
                      p.in[I_DAQG] + L * 64, p.in[I_DAKG] + L * 64, (const float*)(ws + WS_ROPE), (bf16*)(ws + WS_RA + RA_QK), p.in[I_MLCW] + (size_t)L * 3 * 2048, p.in[I_MLCB] + L * 2048};
    pg8::gemm_phase<pg8::EpiInproj, pg8::StaticOrder, true, true>(lds, g, S, E); }
__device__ __forceinline__ void phase_glu(const P& p, int L, LAS unsigned char* lds, int bid, int nblk) { unsigned char* const ws = lp_(p.ws);
    pg8::Gemm g{(const bf16*)(ws + WS_RA + RA_Z5), (const bf16*)(ws + WS_WGLU + L * SZ_WGLU), MROWS, MIXW, MIXW}; pg8::StaticOrder S; S.init(MROWS, MIXW, nblk, bid);
    pg8::EpiGlu E{(const bf16*)(ws + WS_RA + RA_Z5), (bf16*)(ws + WS_RA + RA_YB), p.in[I_GLUB] + L * MIXW};
    pg8::gemm_phase<pg8::EpiGlu, pg8::StaticOrder, true, true>(lds, g, S, E); }
__device__ __forceinline__ void phase_branch(const P& p, int L, LAS unsigned char* lds, int bid, int nblk, int mode) { unsigned char* const ws = lp_(p.ws);
    pg8::Gemm g{(const bf16*)(ws + WS_RA + RA_YA), (const bf16*)(ws + WS_WBR + L * SZ_WBR), 3 * MROWS, DM, MIXW}; pg8::BranchOrder S; S.T.init(MROWS, DM, nblk, bid, mode);
    pg8::EpiBranch E{(const bf16*)(ws + WS_RA + RA_PROJ) + C_GB, (bf16*)(ws + WS_RA + RA_MGB)};
    pg8::gemm_phase<pg8::EpiBranch, pg8::BranchOrder, true, true>(lds, g, S, E); }
__device__ __forceinline__ void phase_outproj(const P& p, int L, LAS unsigned char* lds, int bid, int nblk, int mode, size_t zofs = WS_Z) { unsigned char* const ws = lp_(p.ws);
    pg8::Gemm g{(const bf16*)(ws + WS_RA + RA_MGB), (const bf16*)(ws + WS_WOUT + L * SZ_WOUT), MROWS, DM, DM}; pg8::StaticOrder S; S.init(MROWS, DM, nblk, bid, mode);
    pg8::EpiOut E{(bf16*)(ws + zofs), (const float*)(ws + WS_MOD) + (size_t)L * 5 * 6 * DM};
    pg8::gemm_phase<pg8::EpiOut, pg8::StaticOrder, true, true>(lds, g, S, E); }
__device__ __forceinline__ void moe_prefix(const P& p, int L, int* pre) { unsigned char* const ws = lp_(p.ws);
    if (tid_() == 0) { const unsigned* cnt = (const unsigned*)(ws + WS_CTL) + CW_MOECNT + L * 1024; int a = 0;
        for (int e = 0; e < 16; ++e) { pre[e] = a; a += (int)((__hip_atomic_load(cnt + e * 64, __ATOMIC_RELAXED, __HIP_MEMORY_SCOPE_AGENT) + 255u) >> 8); } pre[16] = a; }
    __syncthreads();
}
__device__ __forceinline__ void phase_moe_gu(const P& p, int L, LAS unsigned char* lds, int* pre, int bid, int nblk) { unsigned char* const ws = lp_(p.ws);
    pg8::Gemm g{(const bf16*)(ws + WS_RA), (const bf16*)(ws + WS_WGU + L * SZ_WGU), NEXP * ECAP, 2 * DFF, DM}; pg8::MoeOrder S{pre, 4, nblk, bid};
    pg8::EpiGateUp E{(bf16*)(ws + WS_ACT)};
    pg8::gemm_phase<pg8::EpiGateUp, pg8::MoeOrder, true, true>(lds, g, S, E); }
__device__ __forceinline__ void phase_moe_dn(const P& p, int L, LAS unsigned char* lds, int* pre, int bid, int nblk) { unsigned char* const ws = lp_(p.ws);
    pg8::Gemm g{(const bf16*)(ws + WS_ACT), (const bf16*)(ws + WS_WDN + L * SZ_WDN), NEXP * ECAP, DM, DFF}; pg8::MoeOrder S{pre, 8, nblk, bid};
    pg8::EpiPlainBf16 E{(bf16*)(ws + WS_RA), DM};
    pg8::gemm_phase<pg8::EpiPlainBf16, pg8::MoeOrder, true, true>(lds, g, S, E); }

#define XB_TMO      128
#define XB_XCNT(j)  (256  + 64 * (j))
#define XB_XSUB(j)  (1280 + 64 * (j))
#define XB_XGEN(j)  (2304 + 64 * (j))
#define XB_TOP      3328
#define XB_TOPGEN   3392
#define XCD_BAR_WORDS 3456
#define XB_SPIN_CAP (1u << 18)

__device__ __forceinline__ unsigned xb_ld(unsigned* p)              { return __hip_atomic_load(p, __ATOMIC_RELAXED, __HIP_MEMORY_SCOPE_AGENT); }
__device__ __forceinline__ unsigned xb_add(unsigned* p, unsigned v) { return __hip_atomic_fetch_add(p, v, __ATOMIC_RELAXED, __HIP_MEMORY_SCOPE_AGENT); }
__device__ __forceinline__ unsigned xb_xcc_id() { return (unsigned)__builtin_amdgcn_s_getreg((3 << 11) | 20) & 0xFu; }
#define XB_SPIN(cond, bar) do { unsigned _sp = 0; while (cond) { __builtin_amdgcn_s_sleep(1); \
    if ((++_sp & 255u) == 0u) { if (xb_ld(&(bar)[XB_TMO])) break; if (_sp > XB_SPIN_CAP) { atomicAdd(&(bar)[XB_TMO], 1u); break; } } } } while (0)

struct XcdBarrier {
    unsigned* bar; unsigned x;
    volatile LAS unsigned* st;
};

__device__ __forceinline__ XcdBarrier xcd_barrier_post(unsigned* bar, volatile LAS unsigned* st) {
    XcdBarrier b; b.bar = bar; b.x = (unsigned)__builtin_amdgcn_readfirstlane((int)xb_xcc_id()); b.st = st;
    if (threadIdx.x == 0) (void)xb_add(&bar[XB_XCNT(b.x)], 1u);
    return b;
}
__device__ __forceinline__ void xcd_barrier_complete(unsigned* bar, unsigned x, unsigned& nloc, unsigned& nx) {
    const unsigned G = gridDim.x * gridDim.y * gridDim.z;
    unsigned sum, cnt, mine, sp = 0u;
    for (;;) {
        sum = 0u; cnt = 0u; mine = 0u;
#pragma unroll
        for (unsigned j = 0; j < 16; ++j) { const unsigned c = xb_ld(&bar[XB_XCNT(j)]); sum += c; cnt += (c > 0u) ? 1u : 0u; mine = (j == x) ? c : mine; }
        if (sum == G) break;
        __builtin_amdgcn_s_sleep(1);
        if ((++sp & 255u) == 0u) { if (xb_ld(&bar[XB_TMO])) break; if (sp > XB_SPIN_CAP) { atomicAdd(&bar[XB_TMO], 1u); break; } }
    }
    nloc = mine > 0u ? mine : 1u; nx = cnt > 0u ? cnt : 1u;
}

__device__ __forceinline__ void xcd_barrier(const XcdBarrier& b) {
    asm volatile("s_waitcnt vmcnt(0)" ::: "memory");
    __syncthreads();
    if (tid_() == 0) {
        unsigned* bar = lp_(b.bar); unsigned bx = b.x; asm volatile("" : "+s"(bx));
        __builtin_amdgcn_s_waitcnt(0);
        unsigned nloc = b.st[0], nx = b.st[1];
        if (nloc == 0u) { xcd_barrier_complete(bar, bx, nloc, nx); b.st[0] = nloc; b.st[1] = nx; }
        const unsigned old = xb_add(&bar[XB_XSUB(bx)], 1u);
        const unsigned gen = old / nloc;
        if (old + 1u == (gen + 1u) * nloc) {
            __builtin_amdgcn_fence(__ATOMIC_RELEASE, "agent");
            asm volatile("s_waitcnt vmcnt(0)" ::: "memory");
            const unsigned og = xb_add(&bar[XB_TOP], 1u);
            const unsigned tg = og / nx;
            if (og + 1u == (tg + 1u) * nx) xb_add(&bar[XB_TOPGEN], 1u);
            else XB_SPIN(xb_ld(&bar[XB_TOPGEN]) == tg, bar);
            __builtin_amdgcn_fence(__ATOMIC_ACQUIRE, "agent");
            xb_add(&bar[XB_XGEN(bx)], 1u);
            asm volatile("s_waitcnt vmcnt(0)" ::: "memory");
        } else {
            XB_SPIN(xb_ld(&bar[XB_XGEN(bx)]) == gen, bar);
            __builtin_amdgcn_fence(__ATOMIC_ACQUIRE, "agent");
            asm volatile("s_waitcnt vmcnt(0)" ::: "memory");
        }
    }
    __syncthreads();
}

constexpr int CW_BAR = 4096;
static_assert(CW_BAR + XCD_BAR_WORDS <= CW_ATTNQ && CW_ATTNQ + DEPTH * 64 <= CW_MOECNT, "control word map");
constexpr int LDS_BYTES = 147456;
constexpr int LDS_MISC = 143360;
__global__ void __launch_bounds__(NT, 2) mk_fwd(P p) {
    extern __shared__ __attribute__((aligned(16))) unsigned char lds_[];
    LAS unsigned char* lds = (LAS unsigned char*)lds_;
    const int bid = blockIdx.x, nblk = gridDim.x;
    for (int u = threadIdx.x; u < (LDS_BYTES - LDS_MISC) / 4; u += NT) ((LAS unsigned*)(lds + LDS_MISC))[u] = 0u;
    __syncthreads();
    static_assert(LDS_TIDTAB == LDS_MISC + 1024, "tid table sits in the LDS misc region");
    if ((threadIdx.x & 63) == 0) *(LAS int*)(lds + LDS_TIDTAB + ((unsigned)__builtin_amdgcn_s_getreg((6 << 11) | 4) & 63u) * 4) = (int)(threadIdx.x >> 6);
    __syncthreads();
    int* pre = (int*)(lds_ + LDS_MISC);
    XcdBarrier bar = xcd_barrier_post((unsigned*)(p.ws + WS_CTL) + CW_BAR, (volatile LAS unsigned*)(lds + LDS_MISC + 256));
    phase_prologue(p, lds_, bid, nblk);
    xcd_barrier(bar);
    prologue_s5tables(p, lds_, bid, nblk);
    if (PROBE_DUP == 10) prologue_s5tables(p, lds_, bid, nblk);
    xcd_barrier(bar);
    if (PROBE_DUP == 17) { phase_prologue(p, lds_, bid, nblk); xcd_barrier(bar); prologue_s5tables(p, lds_, bid, nblk); xcd_barrier(bar); }
    for (int L = 0; L < DEPTH; ++L) {
        phase_norm1(p, L, lds_, bid, nblk);
        if (PROBE_DUP == 15) { __syncthreads(); phase_norm1<true>(p, L, lds_, bid, nblk); }
        xcd_barrier(bar);
        phase_inproj(p, L, lds, bid, nblk);
        const int fb = IT_P + L * IT_T;
        if (nblk == 256) prologue_transposes(p, lds_, bid, fb, fb + IT_FI, 224, 32);
        if (PROBE_DUP == 2) phase_inproj(p, L, lds, bid, nblk);
        xcd_barrier(bar);
        phase_mlconv(p, L, bid, nblk); phase_s5_gemm1(p, L, lds, bid, nblk);
        if (PROBE_DUP == 8) { phase_mlconv(p, L, bid, nblk); }
        if (PROBE_DUP == 9) phase_s5_gemm1(p, L, lds, bid, nblk);
        xcd_barrier(bar);
        phase_s5_scan(p, L, bid, nblk); phase_mlstm(p, L, lds, bid, nblk); phase_attn(p, L, lds_, bid, nblk);
        if (PROBE_DUP == 3) phase_attn(p, L, lds_, bid, nblk);
        if (PROBE_DUP == 18) phase_s5_scan(p, L, bid, nblk);
        if (PROBE_DUP == 4) phase_mlstm(p, L, lds, bid, nblk);
        xcd_barrier(bar);
        phase_s5_gemm2(p, L, lds, bid, nblk); phase_mlpost(p, L, bid, nblk);
        if (PROBE_DUP == 9) phase_s5_gemm2(p, L, lds, bid, nblk);
        if (PROBE_DUP == 8) phase_mlpost(p, L, bid, nblk);
        xcd_barrier(bar);
        phase_glu(p, L, lds, bid, nblk);
        if (nblk == 256) prologue_transposes(p, lds_, bid, fb + IT_FI, fb + IT_FI + IT_F0, 144, 112);
        if (PROBE_DUP == 12) phase_glu(p, L, lds, bid, nblk);
        xcd_barrier(bar);
        if (L == DEPTH - 1 || nblk != 256) {
            const int md = L == DEPTH - 1 ? 1 : 0;
            phase_branch(p, L, lds, bid, nblk, md);
            xcd_barrier(bar);
            phase_outproj(p, L, lds, bid, nblk, md);
            xcd_barrier(bar);
            phase_norm2(p, L, lds_, bid, nblk, md);
            xcd_barrier(bar);
        } else {
            phase_branch(p, L, lds, bid, nblk, 1);
            xcd_barrier(bar);
            if (bid < 32) phase_branch(p, L, lds, bid, 32, 2);
            else { phase_outproj(p, L, lds, bid - 32, 224, 1);
                   prologue_transposes(p, lds_, bid, fb + IT_FI + IT_F0, fb + IT_FI + IT_F1, 64, 192); }
            xcd_barrier(bar);
            if (bid < 32) phase_outproj(p, L, lds, bid, 32, 2);
            else phase_norm2(p, L, lds_, bid - 32, 224, 1);
            xcd_barrier(bar);
            phase_norm2(p, L, lds_, bid, nblk, 2);
            xcd_barrier(bar);
        }
        moe_prefix(p, L, pre);
        phase_moe_gu(p, L, lds, pre, bid, nblk);
        if (nblk == 256) { const int tot = pre[16] * 4, b0 = tot > 256 ? min(tot - 256, 256) : 0;
            const int g0 = fb + IT_FI + (L + 1 < DEPTH ? IT_F1 : IT_F0), g1 = L + 1 < DEPTH ? fb + IT_T : fb + IT_SH;
            if (tot <= 512) prologue_transposes(p, lds_, bid, g0, g1, b0, 256 - b0); else { __syncthreads(); prologue_transposes(p, lds_, bid, g0, g1, 0, 256); } }
        if (PROBE_DUP == 6) phase_moe_gu(p, L, lds, pre, bid, nblk);
        xcd_barrier(bar);
        phase_moe_dn(p, L, lds, pre, bid, nblk);
        if (PROBE_DUP == 7) phase_moe_dn(p, L, lds, pre, bid, nblk);
        xcd_barrier(bar);
    }
    phase_final(p, bid, nblk);
}

extern "C" void kernel_launch(void* const* d_in, const int* in_sizes, int n_in, void* d_out, int out_size, void* d_ws, size_t ws_size, hipStream_t stream) {
    static int grid = 0;
    if (grid == 0) {
        if (n_in != 37 || ws_size < WS_END || out_size != NB * SEQ * DM) { fprintf(stderr, "kernel_launch: unexpected shapes (n_in %d, ws %zu < %zu?, out %d)\n", n_in, ws_size, (size_t)WS_END, out_size); grid = -1; return; }
        int dev = 0, cus = 0, per_cu = 0; (void)hipGetDevice(&dev); (void)hipDeviceGetAttribute(&cus, hipDeviceAttributeMultiprocessorCount, dev);
        if (hipFuncSetAttribute((const void*)mk_fwd, hipFuncAttributeMaxDynamicSharedMemorySize, LDS_BYTES) != hipSuccess) { fprintf(stderr, "hipFuncSetAttribute failed\n"); grid = -1; return; }
        if (hipOccupancyMaxActiveBlocksPerMultiprocessor(&per_cu, (const void*)mk_fwd, NT, LDS_BYTES) != hipSuccess || per_cu < 1) { fprintf(stderr, "occupancy query: %d blocks per CU\n", per_cu); (void)hipGetLastError(); }
        grid = cus > 0 ? cus : 256;
    }
    if (grid < 0) return;
    (void)hipMemsetAsync((char*)d_ws + WS_CTL, 0, 1 * MiB, stream);
    P p{}; for (int i = 0; i < 37; ++i) p.in[i] = (const float*)d_in[i]; p.out = (float*)d_out; p.ws = (unsigned char*)d_ws; p.layer = 0; p.pad = 0;
    hipLaunchKernelGGL(mk_fwd, dim3(grid), dim3(NT), LDS_BYTES, stream, p);
    const hipError_t le = hipPeekAtLastError();
    if (le != hipSuccess) fprintf(stderr, "kernel_launch: launch failed: %s\n", hipGetErrorName(le));
}
```
